# Optimizing an MI355X kernel written in HIP

```python
import math
import jax, jax.numpy as jnp
from jax import lax
import numpy as np

D_MODEL = 1024
BATCH = 32
SEQ = 2048
DEPTH = 1
DEC_BATCH = 8
DEC_SEQ = 4096
PAST_LEN = 128

A_HEADS = D_MODEL // 128
A_DK = 64
A_DV = 2 * A_DK
AQK = A_HEADS * 2 * A_DK
AW = A_HEADS * A_DV
ROT_DIM = A_DK // 4
ROPE_THETA = 500000.0
Q_BLOCK = 128
R_N = 64
R_HEADS = D_MODEL // R_N
RW = R_HEADS * R_N
W_LORA = 64
A_LORA = 64
CONV_W = 3
GN_EPS = 64e-5
P_SIZES = (AQK, AQK, AW, AW, 3 * RW, RW, 2 * W_LORA, 2 * A_LORA, D_MODEL, D_MODEL)
P_IN = AQK + AQK + AW + AW + 3 * RW + RW + 2 * W_LORA + 2 * A_LORA + D_MODEL + D_MODEL

kernel_name = "hybrid_diffattn_rwkv7_bidir_encoder"


def _rms(x, g, eps=1e-6):
    xf = x.astype(jnp.float32)
    y = xf * lax.rsqrt(jnp.mean(xf * xf, axis=-1, keepdims=True) + eps)
    return (y * g.astype(jnp.float32)).astype(x.dtype)


def _rope_partial(x, pos):
    half = ROT_DIM // 2
    inv = ROPE_THETA ** (-jnp.arange(0, ROT_DIM, 2, dtype=jnp.float32) / ROT_DIM)
    ang = pos.astype(jnp.float32)[:, None] * inv[None, :]
    cos = jnp.cos(ang)[None, :, None, None, :]
    sin = jnp.sin(ang)[None, :, None, None, :]
    xr = x[..., :ROT_DIM].astype(jnp.float32)
    x1, x2 = xr[..., :half], xr[..., half:]
    rot = jnp.concatenate([x1 * cos - x2 * sin, x2 * cos + x1 * sin], axis=-1).astype(x.dtype)
    return jnp.concatenate([rot, x[..., ROT_DIM:]], axis=-1)


def _diff_attention(q, k, v, lam):
    B, S = q.shape[0], q.shape[1]
    nb = S // Q_BLOCK
    qb = q.reshape(B, nb, Q_BLOCK, A_HEADS, 2, A_DK).swapaxes(0, 1)
    scale = A_DK ** -0.5

    def block(qi):
        s = jnp.einsum('bqhmd,bkhmd->bhmqk', qi, k).astype(jnp.float32) * scale
        p = jax.nn.softmax(s, axis=-1)
        diff = p[:, :, 0] - lam * p[:, :, 1]
        return jnp.einsum('bhqk,bkhe->bqhe', diff.astype(v.dtype), v)

    o = lax.map(block, qb)
    return o.swapaxes(0, 1).reshape(B, S, A_HEADS, A_DV)


def _rwkv7_scan(r, w, k, v, kk, a):
    B, S, H, N = r.shape

    def step(state, inp):
        r_t, w_t, k_t, v_t, kk_t, a_t = inp
        sa = jnp.einsum('bhvk,bhk->bhv', state, -kk_t)
        state = (state * w_t[:, :, None, :]
                 + sa[..., None] * (kk_t * a_t)[:, :, None, :]
                 + v_t[..., None] * k_t[:, :, None, :])
        return state, jnp.einsum('bhvk,bhk->bhv', state, r_t)

    xs = tuple(jnp.moveaxis(t, 1, 0) for t in (r, w, k, v, kk, a))
    s0 = jnp.zeros((B, H, N, N), jnp.float32)
    _, o = lax.scan(step, s0, xs)
    return jnp.moveaxis(o, 0, 1)


def _centred_dwconv(x, w):
    pad = CONV_W // 2
    S = x.shape[1]
    xp = jnp.pad(x, ((0, 0), (pad, pad), (0, 0)))
    out = xp[:, 0:S] * w[0]
    for i in range(1, CONV_W):
        out = out + xp[:, i:i + S] * w[i]
    return out


def _layer(x, l, norm_g, w_in, conv_rkv, lam_q1, lam_k1, lam_q2, lam_k2, attn_subln_g,
           w_lora_up, w0, a_lora_up, a0, k_k, k_a, r_k, ln_x_g, ln_x_b,
           w_o_attn, w_o_rwkv, w_out):
    B, S, _ = x.shape
    f32 = jnp.float32
    xn = _rms(x, norm_g)
    h = jnp.einsum('bsd,dp->bsp', xn, w_in)
    pts = []
    acc = 0
    for sz in P_SIZES[:-1]:
        acc += sz
        pts.append(acc)
    q, k, v, g_a, rkv, g_r, w_low, a_low, gm_a, gm_b = jnp.split(h, pts, axis=-1)

    pos = jnp.arange(S)
    q = _rope_partial(q.reshape(B, S, A_HEADS, 2, A_DK), pos)
    k = _rope_partial(k.reshape(B, S, A_HEADS, 2, A_DK), pos)
    v = v.reshape(B, S, A_HEADS, A_DV)
    lam_init = 0.8 - 0.6 * math.exp(-0.3 * l)
    lam = (jnp.exp(jnp.sum(lam_q1.astype(f32) * lam_k1.astype(f32)))
           - jnp.exp(jnp.sum(lam_q2.astype(f32) * lam_k2.astype(f32))) + lam_init)
    o_a = _diff_attention(q, k, v, lam)
    o_a = _rms(o_a, attn_subln_g, eps=1e-5) * (1.0 - lam_init)
    y_a = jnp.einsum('bsc,cd->bsd', o_a.reshape(B, S, AW) * jax.nn.silu(g_a), w_o_attn)

    rkv = _centred_dwconv(rkv, conv_rkv)
    r, kr, vr = jnp.split(rkv, 3, axis=-1)
    r_h = r.reshape(B, S, R_HEADS, R_N).astype(f32)
    k_h = kr.reshape(B, S, R_HEADS, R_N).astype(f32)
    v_h = vr.reshape(B, S, R_HEADS, R_N).astype(f32)
    kk = k_h * k_k.reshape(R_HEADS, R_N).astype(f32)
    kk = kk * lax.rsqrt(jnp.sum(kk * kk, axis=-1, keepdims=True) + 1e-12)
    w_low = w_low.reshape(B, S, 2, W_LORA)
    a_low = a_low.reshape(B, S, 2, A_LORA)
    w_log = -jax.nn.softplus(-(w0 + jnp.einsum('bsdr,drc->bsdc', jnp.tanh(w_low), w_lora_up))) - 0.5
    decay = jnp.exp(-jnp.exp(w_log.astype(f32))).reshape(B, S, 2, R_HEADS, R_N)
    a = jax.nn.sigmoid((a0 + jnp.einsum('bsdr,drc->bsdc', a_low, a_lora_up)).astype(f32))
    a = a.reshape(B, S, 2, R_HEADS, R_N)
    k_dir = k_h[:, :, None] * (1.0 + (a - 1.0) * k_a.reshape(R_HEADS, R_N).astype(f32))
    o_f = _rwkv7_scan(r_h, decay[:, :, 0], k_dir[:, :, 0], v_h, kk, a[:, :, 0])
    fl = lambda t: jnp.flip(t, axis=1)
    o_b = fl(_rwkv7_scan(fl(r_h), fl(decay[:, :, 1]), fl(k_dir[:, :, 1]), fl(v_h), fl(kk), fl(a[:, :, 1])))
    o_r = o_f + o_b
    mu = jnp.mean(o_r, axis=-1, keepdims=True)
    var = jnp.mean(jnp.square(o_r - mu), axis=-1, keepdims=True)
    o_n = ((o_r - mu) * lax.rsqrt(var + GN_EPS) * ln_x_g.reshape(R_HEADS, R_N).astype(f32)
           + ln_x_b.reshape(R_HEADS, R_N).astype(f32))
    bonus = jnp.sum(r_h * k_h * r_k.reshape(R_HEADS, R_N).astype(f32), axis=-1, keepdims=True) * v_h
    o_r = (o_n + bonus).reshape(B, S, RW).astype(x.dtype)
    y_r = jnp.einsum('bsc,cd->bsd', o_r * jax.nn.silu(g_r), w_o_rwkv)

    m = jax.nn.sigmoid(gm_a) * y_a + jax.nn.sigmoid(gm_b) * y_r
    return jnp.einsum('bsd,de->bse', m, w_out)


def _encode(x, layer_params, final_g):
    for l in range(DEPTH):
        x = x + _layer(x, l, *[p[l] for p in layer_params])
    return _rms(x, final_g)


def setup_inputs(seed: int = 0) -> dict:
    key = jax.random.key(seed)
    ks = jax.random.split(key, 26)
    f32 = jnp.float32
    nrm = lambda kk, shape, scale: scale * jax.random.normal(kk, shape, f32)
    return {
        "x_prompt": nrm(ks[0], (BATCH, SEQ, D_MODEL), 1.0),
        "x_sample": nrm(ks[1], (DEC_BATCH, DEC_SEQ, D_MODEL), 1.0),
        "norm_g": 1.0 + nrm(ks[2], (DEPTH, D_MODEL), 0.02),
        "w_in": nrm(ks[3], (DEPTH, D_MODEL, P_IN), D_MODEL ** -0.5),
        "conv_rkv": nrm(ks[4], (DEPTH, CONV_W, 3 * RW), CONV_W ** -0.5),
        "lam_q1": nrm(ks[5], (DEPTH, A_DK), 0.1),
        "lam_k1": nrm(ks[6], (DEPTH, A_DK), 0.1),
        "lam_q2": nrm(ks[7], (DEPTH, A_DK), 0.1),
        "lam_k2": nrm(ks[8], (DEPTH, A_DK), 0.1),
        "attn_subln_g": 1.0 + nrm(ks[9], (DEPTH, A_DV), 0.02),
        "w_lora_up": nrm(ks[10], (DEPTH, 2, W_LORA, RW), 0.1 * W_LORA ** -0.5),
        "w0": jax.random.uniform(ks[11], (DEPTH, 2, RW), f32, -3.0, 0.0),
        "a_lora_up": nrm(ks[12], (DEPTH, 2, A_LORA, RW), 0.1 * A_LORA ** -0.5),
        "a0": nrm(ks[13], (DEPTH, 2, RW), 0.1),
        "k_k": 0.85 + nrm(ks[14], (DEPTH, RW), 0.02),
        "k_a": 1.0 + nrm(ks[15], (DEPTH, RW), 0.02),
        "r_k": nrm(ks[16], (DEPTH, RW), 0.1),
        "ln_x_g": 1.0 + nrm(ks[17], (DEPTH, RW), 0.02),
        "ln_x_b": nrm(ks[18], (DEPTH, RW), 0.02),
        "w_o_attn": nrm(ks[19], (DEPTH, AW, D_MODEL), AW ** -0.5),
        "w_o_rwkv": nrm(ks[20], (DEPTH, RW, D_MODEL), RW ** -0.5),
        "w_out": nrm(ks[21], (DEPTH, D_MODEL, D_MODEL), D_MODEL ** -0.5),
        "final_g": 1.0 + nrm(ks[22], (D_MODEL,), 0.02),
    }


def reference(x_prompt, x_sample, norm_g, w_in, conv_rkv, lam_q1, lam_k1, lam_q2, lam_k2,
              attn_subln_g, w_lora_up, w0, a_lora_up, a0, k_k, k_a, r_k, ln_x_g, ln_x_b,
              w_o_attn, w_o_rwkv, w_out, final_g):
    layer_params = (norm_g, w_in, conv_rkv, lam_q1, lam_k1, lam_q2, lam_k2, attn_subln_g,
                    w_lora_up, w0, a_lora_up, a0, k_k, k_a, r_k, ln_x_g, ln_x_b,
                    w_o_attn, w_o_rwkv, w_out)
    y_prompt = _encode(x_prompt, layer_params, final_g)
    y_sample = _encode(x_sample, layer_params, final_g)
    return (y_prompt, y_sample)
```

```cpp
#include <hip/hip_runtime.h>
#include <hip/hip_bf16.h>
#include <hip/hip_cooperative_groups.h>
#include <cstdio>
#include <cstdint>
namespace cg = cooperative_groups;

constexpr int DM = 1024, PIN = 10496, TCH = 16384, NCHUNK = 6;
constexpr int NTOK_P = 32 * 2048, NTOK_S = 8 * 4096, NTOK = NTOK_P + NTOK_S;
constexpr int C_Q = 0, C_K = 1024, C_V = 2048, C_GA = 3072, C_RKV = 4096, C_GR = 7168, C_WL = 8192, C_GMA = 8448, C_GMB = 9472;
constexpr size_t MiB = 1u << 20;
constexpr size_t WS_CTL = 0;
constexpr size_t WS_WIN = 1 * MiB;
constexpr size_t WS_WOA = 22 * MiB, WS_WOR = 24 * MiB, WS_WOUT = 26 * MiB, WS_WLORA = 28 * MiB;
constexpr size_t WS_ROPE = 30 * MiB;
constexpr size_t WS_BONUS = 31 * MiB;
constexpr size_t WS_XN = 32 * MiB;
constexpr size_t WS_H = 64 * MiB;
constexpr size_t WS_CONV = 392 * MiB;
constexpr size_t WS_LORA = 520 * MiB;
constexpr size_t WS_ATT = 648 * MiB;
constexpr size_t WS_OF = 776 * MiB, WS_OB = 840 * MiB;
constexpr size_t WS_OA = 904 * MiB, WS_ORG = 936 * MiB;
constexpr size_t WS_M = 968 * MiB;
constexpr size_t WS_END = 1000 * MiB;

#define LAS __attribute__((address_space(3)))
typedef unsigned short bf16_t;
typedef short bf16x8 __attribute__((ext_vector_type(8)));
typedef short s16x4 __attribute__((ext_vector_type(4)));
typedef float f32x4 __attribute__((ext_vector_type(4)));
typedef float f32x2 __attribute__((ext_vector_type(2)));
typedef float f32x8 __attribute__((ext_vector_type(8)));
typedef float f32x16 __attribute__((ext_vector_type(16)));
typedef unsigned u32x4 __attribute__((ext_vector_type(4)));
typedef unsigned u32x2 __attribute__((ext_vector_type(2)));

__device__ __forceinline__ unsigned cvt_pk_bf16(float lo, float hi) { unsigned r; asm volatile("v_cvt_pk_bf16_f32 %0, %1, %2" : "=v"(r) : "v"(lo), "v"(hi)); return r; }
__device__ __forceinline__ float bf_lo(unsigned w) { return __uint_as_float(w << 16); }
__device__ __forceinline__ float bf_hi(unsigned w) { return __uint_as_float(w & 0xffff0000u); }
__device__ __forceinline__ float bf1(bf16_t h) { return __uint_as_float(((unsigned)h) << 16); }
__device__ __forceinline__ float fsigmoid(float x) { return __builtin_amdgcn_rcpf(1.0f + __builtin_amdgcn_exp2f(-1.4426950408889634f * x)); }
__device__ __forceinline__ float ftanh(float x) { float t = __builtin_amdgcn_exp2f(2.8853900817779268f * x); return 1.0f - 2.0f * __builtin_amdgcn_rcpf(t + 1.0f); }
__device__ __forceinline__ float wave_sum(float v) {
#pragma unroll
    for (int o = 1; o < 64; o <<= 1) v += __shfl_xor(v, o);
    return v;
}

namespace pg8 {
constexpr int BM = 256, BK = 64, HALF = 128, HTB = HALF * BK * 2, STAGE_BYTES = 8 * HTB, NXCD = 8, WGM = 8;
__host__ __device__ __forceinline__ int lds_byte(int r, int c) { const int st = (r >> 4) * 2 + (c >> 5), rr = r & 15, cc = c & 31, ob = rr * 64 + cc * 2; return st * 1024 + (ob ^ (((ob >> 9) & 1) << 5)); }
__host__ __device__ __forceinline__ void stage_rc(int b, int& R, int& C) { const int st = b / 1024, sb = b % 1024, swz = sb ^ (((sb >> 9) & 1) << 5); R = (st >> 1) * 16 + swz / 64; C = (st & 1) * 32 + (swz % 64) / 2; }
__host__ __device__ __forceinline__ int perm32(int rho) { const int n = rho >> 4, i = rho & 15; return 8 * (i >> 2) + 4 * n + (i & 3); }
struct Unit { int pm, pn; };
struct Gemm { const bf16_t* A; const bf16_t* Bt; int M, N, K, lda, ldb; };
struct StaticOrder {
    int nM, nN, nwg, G, c;
    __device__ void init(int M, int N, int G_, int c_) { nM = M / BM; nN = N / BM; nwg = nM * nN; G = G_; c = c_; }
    __device__ bool next(int i, Unit& u) const {
        const long L = (long)i * G + c; if (L >= nwg) return false;
        int wgid = (int)L; { const int q = nwg / NXCD, r = nwg % NXCD, xcd = wgid % NXCD, off = wgid / NXCD; wgid = (xcd < r ? xcd * (q + 1) : r * (q + 1) + (xcd - r) * q) + off; }
        const int nig = WGM * nN, gid = wgid / nig, fm = gid * WGM, gsz = (nM - fm) < WGM ? (nM - fm) : WGM;
        u.pm = fm + ((wgid % nig) % gsz); u.pn = (wgid % nig) / gsz; return true;
    }
};
template <class F> __device__ __forceinline__ void epi_foreach(const f32x4 (&acc)[2][2][4][2], const Unit& u, int wr, int wc, int fr, int fq, const F& f) {
    const int row0 = u.pm * BM + wr * 64 + fr, col0 = u.pn * BM + wc * 32 + 8 * fq;
#pragma unroll
    for (int ai = 0; ai < 2; ++ai)
#pragma unroll
        for (int m = 0; m < 4; ++m)
#pragma unroll
            for (int bj = 0; bj < 2; ++bj) { f(row0 + ai * HALF + m * 16, col0 + bj * HALF, acc[ai][bj][m][0], acc[ai][bj][m][1]); asm volatile("" ::: "memory"); }
}

template <class Epi>
__device__ __forceinline__ void gemm_phase(LAS unsigned char* lds, const Gemm g, const StaticOrder& S, const Epi& E, const int tid) {
    const int wid = __builtin_amdgcn_readfirstlane(tid >> 6), lane = tid & 63, wr = wid >> 2, wc = wid & 3, fr = lane & 15, fq = lane >> 4;
    const int K = g.K, nt = K / BK;
    unsigned voffA[2], voffB[2];
#pragma unroll
    for (int i = 0; i < 2; ++i) { int R, C; stage_rc(tid * 16 + i * 8192, R, C); const int Rb = (R & ~31) + perm32(R & 31);
        voffA[i] = (unsigned)(R * g.lda + C) * 2u; voffB[i] = (unsigned)(Rb * g.ldb + C) * 2u; }
    const size_t kstep = (size_t)(BK * 2);
    const size_t hstepA = (size_t)HALF * g.lda * 2, hstepB = (size_t)HALF * g.ldb * 2;
    const size_t tstepA = 2 * hstepA, tstepB = 2 * hstepB;
    const unsigned ldsw = (unsigned)wid * 1024u;
    const int aoff = lds_byte(wr * 64 + fr, fq * 8), boff = lds_byte(wc * 32 + fr, fq * 8);
#define PG8_SA(b, h) (((b) * 2 + (h)) * HTB)
#define PG8_SB(b, h) ((4 + (b) * 2 + (h)) * HTB)
#define PG8_STAGE(bufoff, gbase, voff) do { _Pragma("unroll") for (int _i = 0; _i < 2; ++_i) \
        __builtin_amdgcn_global_load_lds((const unsigned*)((const char*)(gbase) + (voff)[_i]), (LAS unsigned*)(lds + (bufoff) + ldsw + _i * 8192), 16, 0, 0); } while (0)
#define PG8_LDA(dst, b, h) do { _Pragma("unroll") for (int m = 0; m < 4; ++m) _Pragma("unroll") for (int k = 0; k < 2; ++k) dst[m][k] = *(const LAS bf16x8*)(lds + PG8_SA(b, h) + aoff + m * 2048 + k * 1024); } while (0)
#define PG8_LDB(dst, b, h) do { _Pragma("unroll") for (int n = 0; n < 2; ++n) _Pragma("unroll") for (int k = 0; k < 2; ++k) dst[n][k] = *(const LAS bf16x8*)(lds + PG8_SB(b, h) + boff + n * 2048 + k * 1024); } while (0)
#define PG8_MMA(ai, bj, At, Bt) do { __builtin_amdgcn_s_setprio(1); _Pragma("unroll") for (int m = 0; m < 4; ++m) _Pragma("unroll") for (int n = 0; n < 2; ++n) _Pragma("unroll") for (int k = 0; k < 2; ++k) \
        acc[ai][bj][m][n] = __builtin_amdgcn_mfma_f32_16x16x32_bf16(Bt[n][k], At[m][k], acc[ai][bj][m][n], 0, 0, 0); __builtin_amdgcn_s_setprio(0); } while (0)
#define PG8_WAIT_V(n) asm volatile("s_waitcnt vmcnt(" #n ")" ::: "memory")
#define PG8_WAIT_L(n) asm volatile("s_waitcnt lgkmcnt(" #n ")" ::: "memory")
#define PG8_BAR __builtin_amdgcn_s_barrier()
#define PG8_SCHED __builtin_amdgcn_sched_barrier(0)
    Unit cur, nxt; int ui = 0;
    if (!S.next(0, cur)) return;
    f32x4 acc[2][2][4][2];
#pragma unroll
    for (int a = 0; a < 2; ++a)
#pragma unroll
        for (int b = 0; b < 2; ++b)
#pragma unroll
            for (int m = 0; m < 4; ++m)
#pragma unroll
                for (int n = 0; n < 2; ++n) acc[a][b][m][n] = (f32x4){0.f, 0.f, 0.f, 0.f};
    bf16x8 At[4][2], B0[2][2], B1[2][2];
    const char* cA = (const char*)g.A + (size_t)cur.pm * tstepA; const char* cB = (const char*)g.Bt + (size_t)cur.pn * tstepB;
#define PG8_LAUNDER asm volatile("" : "+v"(voffA[0]), "+v"(voffA[1]), "+v"(voffB[0]), "+v"(voffB[1]))
    PG8_LAUNDER; PG8_STAGE(PG8_SB(0, 0), cB, voffB); PG8_LAUNDER; PG8_STAGE(PG8_SB(0, 1), cB + hstepB, voffB); PG8_LAUNDER; PG8_STAGE(PG8_SA(0, 0), cA, voffA); PG8_LAUNDER; PG8_STAGE(PG8_SA(0, 1), cA + hstepA, voffA);
    if (wr == 1) PG8_BAR;
    PG8_WAIT_V(2); PG8_BAR;
    PG8_LAUNDER; PG8_STAGE(PG8_SB(1, 0), cB + kstep, voffB); PG8_LAUNDER; PG8_STAGE(PG8_SA(1, 0), cA + kstep, voffA); PG8_LAUNDER; PG8_STAGE(PG8_SB(1, 1), cB + hstepB + kstep, voffB);
    PG8_WAIT_V(6); PG8_BAR; PG8_LAUNDER;
    for (;;) {
        const bool has_next = S.next(ui + 1, nxt);
        const char* nA = has_next ? (const char*)g.A + (size_t)nxt.pm * tstepA : cA; const char* nB = has_next ? (const char*)g.Bt + (size_t)nxt.pn * tstepB : cB;
        for (int t = 0; t < nt; t += 2) {
            const bool last = (t == nt - 2);
            const char* a1 = cA + (size_t)(t + 1) * kstep;
            const char* a2 = last ? nA : cA + (size_t)(t + 2) * kstep; const char* b2 = last ? nB : cB + (size_t)(t + 2) * kstep;
            const char* a3 = a2 + kstep; const char* b3 = b2 + kstep;
            PG8_LDB(B0, 0, 0); PG8_LDB(B1, 0, 1); PG8_SCHED; PG8_LDA(At, 0, 0); PG8_STAGE(PG8_SA(1, 1), a1 + hstepA, voffA);
            PG8_WAIT_V(8); PG8_WAIT_L(0); PG8_BAR; PG8_MMA(0, 0, At, B0); PG8_MMA(0, 1, At, B1); PG8_BAR; PG8_SCHED;
            PG8_LDA(At, 0, 1); PG8_STAGE(PG8_SB(0, 0), b2, voffB); PG8_STAGE(PG8_SB(0, 1), b2 + hstepB, voffB); PG8_STAGE(PG8_SA(0, 0), a2, voffA);
            PG8_WAIT_V(8); PG8_WAIT_L(0); PG8_BAR; PG8_MMA(1, 0, At, B0); PG8_MMA(1, 1, At, B1); PG8_BAR; PG8_SCHED;
            PG8_LDB(B0, 1, 0); PG8_LDB(B1, 1, 1); PG8_SCHED; PG8_LDA(At, 1, 0); PG8_STAGE(PG8_SA(0, 1), a2 + hstepA, voffA);
            PG8_WAIT_V(8); PG8_WAIT_L(0); PG8_BAR; PG8_MMA(0, 0, At, B0); PG8_MMA(0, 1, At, B1); PG8_BAR; PG8_SCHED;
            PG8_LDA(At, 1, 1); PG8_STAGE(PG8_SB(1, 0), b3, voffB); PG8_STAGE(PG8_SB(1, 1), b3 + hstepB, voffB); PG8_STAGE(PG8_SA(1, 0), a3, voffA);
            PG8_WAIT_V(8); PG8_WAIT_L(0); PG8_BAR; PG8_MMA(1, 0, At, B0); PG8_MMA(1, 1, At, B1); PG8_BAR; PG8_SCHED;
        }
        if (wr == 0) PG8_BAR;
        { int ln_ = lane; asm volatile("" : "+v"(ln_)); E(acc, cur, wr, wc, ln_ & 15, ln_ >> 4); }
        if (!has_next) break;
#pragma unroll
        for (int a = 0; a < 2; ++a)
#pragma unroll
            for (int b = 0; b < 2; ++b)
#pragma unroll
                for (int m = 0; m < 4; ++m)
#pragma unroll
                    for (int n = 0; n < 2; ++n) acc[a][b][m][n] = (f32x4){0.f, 0.f, 0.f, 0.f};
        cur = nxt; cA = nA; cB = nB; ++ui;
        if (wr == 1) PG8_BAR;
    }
    PG8_WAIT_V(0);
    PG8_BAR;
#undef PG8_SA
#undef PG8_SB
#undef PG8_STAGE
#undef PG8_LDA
#undef PG8_LDB
#undef PG8_MMA
#undef PG8_WAIT_V
#undef PG8_WAIT_L
#undef PG8_BAR
#undef PG8_SCHED
}
}

__device__ __forceinline__ u32x4 pack8(f32x4 v0, f32x4 v1) { u32x4 w; w.x = cvt_pk_bf16(v0[0], v0[1]); w.y = cvt_pk_bf16(v0[2], v0[3]); w.z = cvt_pk_bf16(v1[0], v1[1]); w.w = cvt_pk_bf16(v1[2], v1[3]); return w; }
__device__ __forceinline__ void unpack8(u32x4 w, float* f) { f[0] = bf_lo(w.x); f[1] = bf_hi(w.x); f[2] = bf_lo(w.y); f[3] = bf_hi(w.y); f[4] = bf_lo(w.z); f[5] = bf_hi(w.z); f[6] = bf_lo(w.w); f[7] = bf_hi(w.w); }

struct EpiIn {
    bf16_t* H;
    __device__ __forceinline__ void operator()(const f32x4 (&acc)[2][2][4][2], const pg8::Unit& u, int wr, int wc, int fr, int fq) const {
        bf16_t* Hh = H; const bool lt = (u.pn == C_WL / 256);
        pg8::epi_foreach(acc, u, wr, wc, fr, fq, [&](int row, int col, f32x4 v0, f32x4 v1) {
            if (lt && col < C_WL + 128) {
#pragma unroll
                for (int i = 0; i < 4; ++i) { v0[i] = ftanh(v0[i]); v1[i] = ftanh(v1[i]); }
            }
            *(u32x4*)(Hh + (size_t)row * PIN + col) = pack8(v0, v1); });
    }
};
struct EpiLora {
    bf16_t* O; const float* w0; const float* a0;
    __device__ __forceinline__ void operator()(const f32x4 (&acc)[2][2][4][2], const pg8::Unit& u, int wr, int wc, int fr, int fq) const {
        bf16_t* Oo = O; const bool isw = (u.pn < 8); const float* bias = isw ? w0 : a0;
        pg8::epi_foreach(acc, u, wr, wc, fr, fq, [&](int row, int col, f32x4 v0, f32x4 v1) {
            const int bc = col & 2047;
            const f32x4 b0 = *(const f32x4*)(bias + bc), b1 = *(const f32x4*)(bias + bc + 4);
#pragma unroll
            for (int i = 0; i < 4; ++i) {
                float z0 = v0[i] + b0[i], z1 = v1[i] + b1[i];
                if (isw) { const float e0 = 0.6065306597126334f * fsigmoid(z0), e1 = 0.6065306597126334f * fsigmoid(z1);
                    v0[i] = 1.0f - __builtin_amdgcn_exp2f(-1.4426950408889634f * e0); v1[i] = 1.0f - __builtin_amdgcn_exp2f(-1.4426950408889634f * e1); }
                else { v0[i] = fsigmoid(z0); v1[i] = fsigmoid(z1); }
            }
            *(u32x4*)(Oo + (size_t)row * 4096 + col) = pack8(v0, v1); });
    }
};
struct EpiMa {
    float* MA; const bf16_t* H; int gcol;
    __device__ __forceinline__ void operator()(const f32x4 (&acc)[2][2][4][2], const pg8::Unit& u, int wr, int wc, int fr, int fq) const {
        float* Mm = MA; const bf16_t* Hh = H; const int gc = gcol;
        pg8::epi_foreach(acc, u, wr, wc, fr, fq, [&](int row, int col, f32x4 v0, f32x4 v1) {
            float gt[8]; unpack8(*(const u32x4*)(Hh + (size_t)row * PIN + gc + col), gt);
#pragma unroll
            for (int i = 0; i < 4; ++i) { v0[i] *= fsigmoid(gt[i]); v1[i] *= fsigmoid(gt[4 + i]); }
            float* p = Mm + (size_t)row * DM + col; *(f32x4*)p = v0; *(f32x4*)(p + 4) = v1; });
    }
};
struct EpiM {
    bf16_t* M; const float* MA; const bf16_t* H; int gcol;
    __device__ __forceinline__ void operator()(const f32x4 (&acc)[2][2][4][2], const pg8::Unit& u, int wr, int wc, int fr, int fq) const {
        bf16_t* Mo = M; const float* Mm = MA; const bf16_t* Hh = H; const int gc = gcol;
        pg8::epi_foreach(acc, u, wr, wc, fr, fq, [&](int row, int col, f32x4 v0, f32x4 v1) {
            float gt[8]; unpack8(*(const u32x4*)(Hh + (size_t)row * PIN + gc + col), gt);
            const float* p = Mm + (size_t)row * DM + col; const f32x4 m0 = *(const f32x4*)p, m1 = *(const f32x4*)(p + 4);
#pragma unroll
            for (int i = 0; i < 4; ++i) { v0[i] = m0[i] + v0[i] * fsigmoid(gt[i]); v1[i] = m1[i] + v1[i] * fsigmoid(gt[4 + i]); }
            *(u32x4*)(Mo + (size_t)row * DM + col) = pack8(v0, v1); });
    }
};
struct EpiOut {
    float* out; const float* x;
    __device__ __forceinline__ void operator()(const f32x4 (&acc)[2][2][4][2], const pg8::Unit& u, int wr, int wc, int fr, int fq) const {
        float* oo = out; const float* xx = x;
        pg8::epi_foreach(acc, u, wr, wc, fr, fq, [&](int row, int col, f32x4 v0, f32x4 v1) {
            const size_t off = (size_t)row * DM + col;
            const f32x4 x0 = *(const f32x4*)(xx + off), x1 = *(const f32x4*)(xx + off + 4);
            *(f32x4*)(oo + off) = v0 + x0; *(f32x4*)(oo + off + 4) = v1 + x1; });
    }
};

struct Args {
    const float* x_p; const float* x_s; const float* norm_g; const float* w_in; const float* conv; const float* lq1; const float* lk1; const float* lq2; const float* lk2;
    const float* subln_g; const float* wlu; const float* w0; const float* alu; const float* a0; const float* k_k; const float* k_a; const float* r_k; const float* lnx_g; const float* lnx_b;
    const float* w_oa; const float* w_or; const float* w_out; const float* final_g;
    float* out; unsigned char* ws; int ph_lo, ph_hi;
};
constexpr int NWAVES = 8, NTHR = 512;
constexpr int LDS_BYTES = 147456;

__device__ __forceinline__ void p0_transpose_item(const float* W, int K, int N, bf16_t* WT, LAS float* scr, int item, int lane) {
    const int nblk = N / 32, kb = item / nblk, nb = item % nblk, k0 = 64 * kb, n0 = 32 * nb;
#pragma unroll 8
    for (int i = 0; i < 32; ++i) { const int kk = 2 * i + (lane >> 5); scr[kk * 33 + (lane & 31)] = W[(size_t)(k0 + kk) * N + n0 + (lane & 31)]; }
    asm volatile("s_waitcnt lgkmcnt(0)" ::: "memory");
    const int c = lane & 7;
#pragma unroll
    for (int j = 0; j < 4; ++j) { const int n = (lane >> 3) + 8 * j; const LAS float* s = scr + (8 * c) * 33 + n;
        u32x4 o; o.x = cvt_pk_bf16(s[0 * 33], s[1 * 33]); o.y = cvt_pk_bf16(s[2 * 33], s[3 * 33]); o.z = cvt_pk_bf16(s[4 * 33], s[5 * 33]); o.w = cvt_pk_bf16(s[6 * 33], s[7 * 33]);
        *(u32x4*)(WT + (size_t)(n0 + n) * K + k0 + 8 * c) = o; }
    asm volatile("s_waitcnt lgkmcnt(0)" ::: "memory");
}

__device__ __forceinline__ void phase_weights(const Args& a, LAS unsigned char* lds, int gw, int NGW, int lane, int wave) {
    unsigned char* ws = a.ws;
    LAS float* scr = (LAS float*)(lds + wave * 16384);
    constexpr int I_IN = (DM / 64) * (PIN / 32), I_SQ = (DM / 64) * (DM / 32);
    for (int it = gw; it < I_IN + 3 * I_SQ; it += NGW) {
        int r = it;
        if (r < I_IN) { p0_transpose_item(a.w_in, DM, PIN, (bf16_t*)(ws + WS_WIN), scr, r, lane); continue; } r -= I_IN;
        if (r < I_SQ) { p0_transpose_item(a.w_oa, DM, DM, (bf16_t*)(ws + WS_WOA), scr, r, lane); continue; } r -= I_SQ;
        if (r < I_SQ) { p0_transpose_item(a.w_or, DM, DM, (bf16_t*)(ws + WS_WOR), scr, r, lane); continue; } r -= I_SQ;
        p0_transpose_item(a.w_out, DM, DM, (bf16_t*)(ws + WS_WOUT), scr, r, lane);
    }
    bf16_t* WL = (bf16_t*)(ws + WS_WLORA);
    for (int e = gw * 64 + lane; e < 4096 * 256; e += NGW * 64) {
        const int n = e >> 8, k = e & 255, kind = n >> 10, ch = n & 1023, j = k - 64 * kind;
        float v = 0.f;
        if (j >= 0 && j < 64) { const float* src = (kind < 2) ? a.wlu : a.alu; v = src[((size_t)(kind & 1) * 64 + j) * 1024 + ch]; }
        WL[e] = (bf16_t)(cvt_pk_bf16(v, 0.f) & 0xffffu);
    }
    f32x2* RT = (f32x2*)(ws + WS_ROPE);
    for (int e = gw * 64 + lane; e < 4096 * 8; e += NGW * 64) {
        const int pos = e >> 3, i = e & 7;
        const float inv = exp2f(-(float)i * (0.125f * 18.931568569324174f));
        const float ang = (float)pos * inv;
        const float n = rintf(ang * 0.15915494309189535f);
        float r = fmaf(-n, 6.28125f, ang); r = fmaf(-n, 1.9353071795864769e-3f, r);
        RT[e] = (f32x2){__cosf(r), __sinf(r)};
    }
}

__device__ __forceinline__ void phase_xn(const float* x, const float* g, bf16_t* XN, int nrows, int gw, int NGW, int lane) {
    f32x4 gv[4];
#pragma unroll
    for (int j = 0; j < 4; ++j) gv[j] = ((const f32x4*)g)[lane + 64 * j];
    for (int m = gw; m < nrows; m += NGW) {
        const f32x4* xr = (const f32x4*)(x + (size_t)m * DM) + lane;
        f32x4 v[4]; float s = 0.f;
#pragma unroll
        for (int j = 0; j < 4; ++j) { v[j] = xr[64 * j]; s += (v[j].x * v[j].x + v[j].y * v[j].y) + (v[j].z * v[j].z + v[j].w * v[j].w); }
        const float rstd = 1.0f / sqrtf(wave_sum(s) * (1.f / DM) + 1e-6f);
        u32x2* o8 = (u32x2*)(XN + (size_t)m * DM) + lane;
#pragma unroll
        for (int j = 0; j < 4; ++j) { u32x2 w; w.x = cvt_pk_bf16(v[j].x * rstd * gv[j].x, v[j].y * rstd * gv[j].y); w.y = cvt_pk_bf16(v[j].z * rstd * gv[j].z, v[j].w * rstd * gv[j].w); o8[64 * j] = w; }
    }
}
__device__ __forceinline__ void phase_final(float* out, const float* g, int nrows, int gw, int NGW, int lane) {
    f32x4 gv[4];
#pragma unroll
    for (int j = 0; j < 4; ++j) gv[j] = ((const f32x4*)g)[lane + 64 * j];
    for (int m = gw; m < nrows; m += NGW) {
        f32x4* xr = (f32x4*)(out + (size_t)m * DM) + lane;
        f32x4 v[4]; float s = 0.f;
#pragma unroll
        for (int j = 0; j < 4; ++j) { v[j] = xr[64 * j]; s += (v[j].x * v[j].x + v[j].y * v[j].y) + (v[j].z * v[j].z + v[j].w * v[j].w); }
        const float rstd = 1.0f / sqrtf(wave_sum(s) * (1.f / DM) + 1e-6f);
#pragma unroll
        for (int j = 0; j < 4; ++j) xr[64 * j] = v[j] * rstd * gv[j];
    }
}

__device__ __forceinline__ void phase_prep(const Args& a, int S, int gw, int NGW, int lane) {
    unsigned char* ws = a.ws;
    bf16_t* H = (bf16_t*)(ws + WS_H); bf16_t* CV = (bf16_t*)(ws + WS_CONV); float* BN = (float*)(ws + WS_BONUS);
    const f32x2* RT = (const f32x2*)(ws + WS_ROPE);
    for (int t = gw; t < TCH; t += NGW) {
        const int pos = t % S;
        bf16_t* hr = H + (size_t)t * PIN;
#pragma unroll
        for (int j = 0; j < 4; ++j) {
            const int p = lane + 64 * j, grp = p >> 3, i = p & 7;
            const int col = grp * 64 + i;
            const f32x2 cs = RT[pos * 8 + i];
            const float x1 = bf1(hr[col]), x2 = bf1(hr[col + 8]);
            const unsigned w = cvt_pk_bf16(x1 * cs.x - x2 * cs.y, x2 * cs.x + x1 * cs.y);
            hr[col] = (bf16_t)(w & 0xffffu); hr[col + 8] = (bf16_t)(w >> 16);
        }
        const bool hasp = pos > 0, hasn = pos < S - 1;
        for (int hd = 0; hd < 16; ++hd) {
            float rkv[3];
#pragma unroll
            for (int part = 0; part < 3; ++part) {
                const int ch = part * 1024 + hd * 64 + lane;
                const float xm = hasp ? bf1(hr[C_RKV + ch - PIN]) : 0.f, x0 = bf1(hr[C_RKV + ch]), xp = hasn ? bf1(hr[C_RKV + ch + PIN]) : 0.f;
                rkv[part] = xm * a.conv[ch] + x0 * a.conv[3072 + ch] + xp * a.conv[6144 + ch];
            }
            const int hc = hd * 64 + lane;
            float kk = rkv[1] * a.k_k[hc];
            const float ss = wave_sum(kk * kk);
            kk *= 1.0f / sqrtf(ss + 1e-12f);
            const float bs = wave_sum(rkv[0] * rkv[1] * a.r_k[hc]);
            bf16_t* o = CV + ((size_t)t * 16 + hd) * 256;
            const unsigned w0 = cvt_pk_bf16(rkv[0], rkv[1]), w1 = cvt_pk_bf16(rkv[2], kk);
            o[lane] = (bf16_t)(w0 & 0xffffu); o[64 + lane] = (bf16_t)(w0 >> 16); o[128 + lane] = (bf16_t)(w1 & 0xffffu); o[192 + lane] = (bf16_t)(w1 >> 16);
            if (lane == 0) BN[t * 16 + hd] = bs;
        }
    }
}

namespace att {
constexpr int NW = 8, QBLK = 32, KVBLK = 64;
constexpr float SCALE = 0.125f, THR = 8.f;
constexpr int LDK = PIN, LDO = 2048;
constexpr int SHM_V = KVBLK * 128 * 2, SHM_K = KVBLK * 64 * 2, SHM_ATTN = 2 * SHM_V + 2 * SHM_K + NW * 64 * 4;
#define KSWZ(row, colB) ((row) * 128 + ((colB) ^ (((row) & 7) << 4)))
#define SBAR() __builtin_amdgcn_sched_barrier(0)
__device__ __forceinline__ int crow(int r, int hi) { return (r & 3) + 8 * (r >> 2) + 4 * hi; }
__device__ __forceinline__ void partialSM(f32x16& p0, f32x16& p1, float& m_reg, float& mn, float& alpha) {
  constexpr float C = SCALE * 1.4426950408889634f;
  float pmax = p0[0];
#pragma unroll
  for (int r = 1; r < 16; ++r) pmax = fmaxf(pmax, p0[r]);
#pragma unroll
  for (int r = 0; r < 16; ++r) pmax = fmaxf(pmax, p1[r]);
  { auto rr = __builtin_amdgcn_permlane32_swap(__float_as_uint(pmax), __float_as_uint(pmax), false, false);
    pmax = fmaxf(__uint_as_float(rr[0]), __uint_as_float(rr[1])); }
  if (__builtin_expect(__all(pmax - m_reg <= THR / SCALE), 1)) { mn = m_reg; alpha = 1.f; }
  else { mn = fmaxf(m_reg, pmax); alpha = __builtin_amdgcn_exp2f((m_reg - mn) * C); m_reg = mn; }
  float mnC = -mn * C;
#pragma unroll
  for (int r = 0; r < 16; ++r) p0[r] = fmaf(p0[r], C, mnC);
#pragma unroll
  for (int r = 0; r < 16; ++r) p1[r] = fmaf(p1[r], C, mnC);
#pragma unroll
  for (int r = 0; r < 16; ++r) p0[r] = __builtin_amdgcn_exp2f(p0[r]);
}
__device__ __forceinline__ void finishSM(f32x16& p0, f32x16& p1, float alpha, float& l_reg, bf16x8& pa0, bf16x8& pa1, bf16x8& pa2, bf16x8& pa3) {
#pragma unroll
  for (int r = 0; r < 16; ++r) p1[r] = __builtin_amdgcn_exp2f(p1[r]);
  float ps = 0;
#pragma unroll
  for (int r = 0; r < 16; ++r) ps += p0[r];
#pragma unroll
  for (int r = 0; r < 16; ++r) ps += p1[r];
  { auto rr = __builtin_amdgcn_permlane32_swap(__float_as_uint(ps), __float_as_uint(ps), false, false);
    ps = __uint_as_float(rr[0]) + __uint_as_float(rr[1]); }
  l_reg = l_reg * alpha + ps;
#define PK4(P, BASE, OUT) do { unsigned a0 = cvt_pk_bf16(P[BASE + 0], P[BASE + 1]), a1 = cvt_pk_bf16(P[BASE + 2], P[BASE + 3]);   \
    unsigned b0 = cvt_pk_bf16(P[BASE + 4], P[BASE + 5]), b1 = cvt_pk_bf16(P[BASE + 6], P[BASE + 7]);                              \
    auto r0 = __builtin_amdgcn_permlane32_swap(a0, b0, false, false); auto r1 = __builtin_amdgcn_permlane32_swap(a1, b1, false, false); \
    u32x4 w = {r0[0], r1[0], r0[1], r1[1]}; OUT = *reinterpret_cast<bf16x8*>(&w); } while (0)
  PK4(p0, 0, pa0); PK4(p0, 8, pa1); PK4(p1, 0, pa2); PK4(p1, 8, pa3);
#undef PK4
}
__device__ __forceinline__ void qkt(f32x16& p0, f32x16& p1, const char* Ks, const bf16x8* qr, int r32, int hi) {
  p0 = f32x16{}; p1 = f32x16{};
#pragma unroll
  for (int d0 = 0; d0 < 4; ++d0) { int cb = (d0 * 16 + hi * 8) * 2;
    bf16x8 b0 = *reinterpret_cast<const bf16x8*>(Ks + KSWZ(r32, cb));
    bf16x8 b1 = *reinterpret_cast<const bf16x8*>(Ks + KSWZ(32 + r32, cb));
    p0 = __builtin_amdgcn_mfma_f32_32x32x16_bf16(b0, qr[d0], p0, 0, 0, 0);
    p1 = __builtin_amdgcn_mfma_f32_32x32x16_bf16(b1, qr[d0], p1, 0, 0, 0); }
}
__device__ __forceinline__ int v_st(int k, int c) { const int kk = (k & ~0xC) | ((k & 4) << 1) | ((k & 8) >> 1); return ((kk >> 3) * 4 + (c >> 5)) * 512 + ((kk & 7) * 32 + (c & 31)) * 2; }
__device__ __forceinline__ int v_rd_base(int lane) { return ((lane & 3) << 3) | (((lane >> 2) & 3) << 6) | (((lane >> 4) & 1) << 5) | (((lane >> 5) & 1) << 8); }
constexpr int v_rd_off(int d0, int ks, int half) { return d0 * 512 + ks * 4096 + half * 2048; }
template <int OFF> __device__ __forceinline__ s16x4 tr_read(int vb) {
  s16x4 r; asm volatile("ds_read_b64_tr_b16 %0, %1 offset:%2" : "=&v"(r) : "v"(vb), "i"(OFF) : "memory"); return r;
}
template <int D0> __device__ __forceinline__ void pv_one(f32x16& od, int vb, bf16x8 pa0, bf16x8 pa1, bf16x8 pa2, bf16x8 pa3) {
  const s16x4 l0 = tr_read<v_rd_off(D0, 0, 0)>(vb), h0 = tr_read<v_rd_off(D0, 0, 1)>(vb), l1 = tr_read<v_rd_off(D0, 1, 0)>(vb), h1 = tr_read<v_rd_off(D0, 1, 1)>(vb);
  const s16x4 l2 = tr_read<v_rd_off(D0, 2, 0)>(vb), h2 = tr_read<v_rd_off(D0, 2, 1)>(vb), l3 = tr_read<v_rd_off(D0, 3, 0)>(vb), h3 = tr_read<v_rd_off(D0, 3, 1)>(vb);
  asm volatile("s_waitcnt lgkmcnt(0)" ::: "memory"); SBAR();
#define PK(L, H) (bf16x8){L[0], L[1], L[2], L[3], H[0], H[1], H[2], H[3]}
  od = __builtin_amdgcn_mfma_f32_32x32x16_bf16(pa0, PK(l0, h0), od, 0, 0, 0);
  od = __builtin_amdgcn_mfma_f32_32x32x16_bf16(pa1, PK(l1, h1), od, 0, 0, 0);
  od = __builtin_amdgcn_mfma_f32_32x32x16_bf16(pa2, PK(l2, h2), od, 0, 0, 0);
  od = __builtin_amdgcn_mfma_f32_32x32x16_bf16(pa3, PK(l3, h3), od, 0, 0, 0);
#undef PK
}
__device__ __forceinline__ void pv_d0(f32x16* o, int vb, bf16x8 pa0, bf16x8 pa1, bf16x8 pa2, bf16x8 pa3) {
  pv_one<0>(o[0], vb, pa0, pa1, pa2, pa3); pv_one<1>(o[1], vb, pa0, pa1, pa2, pa3); pv_one<2>(o[2], vb, pa0, pa1, pa2, pa3); pv_one<3>(o[3], vb, pa0, pa1, pa2, pa3);
}
__device__ __forceinline__ void attn_body(const bf16_t* __restrict__ Qb, const bf16_t* __restrict__ Kh, const bf16_t* __restrict__ Vh,
                                          float* __restrict__ Ob, int seq, char* lds, const int tid) {
  const int wid = tid >> 6, lane = tid & 63, r32 = lane & 31, hi = lane >> 5;
  char* V_lds = lds; char* K_lds = lds + 2 * SHM_V;
  float* ws = (float*)(lds + 2 * SHM_V + 2 * SHM_K) + wid * 64; float* li_l = ws; float* al_l = ws + 32;
  float m_reg = -1e30f, l_reg = 0; f32x16 o[4] = {}; bf16x8 qr[4];
  const bf16_t* Qw = Qb + (long)(wid * QBLK + r32) * LDK + hi * 8;
#pragma unroll
  for (int d0 = 0; d0 < 4; ++d0) qr[d0] = *reinterpret_cast<const bf16x8*>(Qw + d0 * 16);
  const int sr = tid >> 4, sc = (tid & 15) * 8, vst0 = v_st(sr, sc), vst1 = v_st(32 + sr, sc);
  const int kr = tid >> 3, kc = (tid & 7) * 8, kst = KSWZ(kr, kc * 2);
  const int vb0 = (int)(uintptr_t)V_lds + v_rd_base(lane);
  struct { bf16x8 vs0, vs1, ks0; } sr_[2];
#define SLOAD(i, k0) do { sr_[i].vs0 = *reinterpret_cast<const bf16x8*>(&Vh[(long)((k0) + sr) * LDK + sc]); sr_[i].vs1 = *reinterpret_cast<const bf16x8*>(&Vh[(long)((k0) + 32 + sr) * LDK + sc]); \
    sr_[i].ks0 = *reinterpret_cast<const bf16x8*>(&Kh[(long)((k0) + kr) * LDK + kc]); } while (0)
#define SWRITE(b, i) do { *(bf16x8*)(V_lds + (b) * SHM_V + vst0) = sr_[i].vs0; *(bf16x8*)(V_lds + (b) * SHM_V + vst1) = sr_[i].vs1; \
    *(bf16x8*)(K_lds + (b) * SHM_K + kst) = sr_[i].ks0; } while (0)
#define SWAIT() asm volatile("s_waitcnt vmcnt(3)" ::: "memory")
#define RESC(a) do { if (__any((a) < 1.f)) { if (hi == 0) al_l[r32] = (a); asm volatile("s_waitcnt lgkmcnt(0)" ::: "memory"); \
    _Pragma("unroll") for (int d = 0; d < 4; ++d) _Pragma("unroll") for (int r = 0; r < 16; ++r) o[d][r] *= al_l[crow(r, hi)]; } } while (0)
  f32x16 pA0, pA1, pB0, pB1; float mnA, mnB, alA, alB; bf16x8 pa0, pa1, pa2, pa3; const int NT = seq / KVBLK;
  constexpr int SE = 0, SO = 1;
  SLOAD(SE, 0); asm volatile("s_waitcnt vmcnt(0)" ::: "memory"); SWRITE(0, SE); __syncthreads();
  qkt(pA0, pA1, K_lds, qr, r32, hi); partialSM(pA0, pA1, m_reg, mnA, alA);
  SLOAD(SO, KVBLK); if (2 < NT) SLOAD(SE, 2 * KVBLK);
  SWAIT(); SWRITE(1, SO); __syncthreads();
  for (int j = 1; j + 1 < NT; j += 2) {
    SBAR(); qkt(pB0, pB1, K_lds + SHM_K, qr, r32, hi);
    finishSM(pA0, pA1, alA, l_reg, pa0, pa1, pa2, pa3); SBAR();
    SLOAD(SO, (j + 2) * KVBLK); SBAR();
    pv_d0(o, vb0, pa0, pa1, pa2, pa3); partialSM(pB0, pB1, m_reg, mnB, alB);
    __syncthreads(); SWAIT(); SWRITE(0, SE);
    RESC(alB); __syncthreads();
    SBAR(); qkt(pA0, pA1, K_lds, qr, r32, hi);
    finishSM(pB0, pB1, alB, l_reg, pa0, pa1, pa2, pa3); SBAR();
    if (j + 3 < NT) SLOAD(SE, (j + 3) * KVBLK); SBAR();
    pv_d0(o, vb0 + (int)SHM_V, pa0, pa1, pa2, pa3); partialSM(pA0, pA1, m_reg, mnA, alA);
    __syncthreads(); SWAIT(); SWRITE(1, SO);
    RESC(alA); __syncthreads();
  }
  SBAR(); qkt(pB0, pB1, K_lds + SHM_K, qr, r32, hi);
  finishSM(pA0, pA1, alA, l_reg, pa0, pa1, pa2, pa3); SBAR();
  pv_d0(o, vb0, pa0, pa1, pa2, pa3); partialSM(pB0, pB1, m_reg, mnB, alB);
  __syncthreads(); RESC(alB);
  finishSM(pB0, pB1, alB, l_reg, pa0, pa1, pa2, pa3); SBAR();
  pv_d0(o, vb0 + (int)SHM_V, pa0, pa1, pa2, pa3);
  if (hi == 0) li_l[r32] = l_reg; asm volatile("s_waitcnt lgkmcnt(0)" ::: "memory");
  float rli[16];
#pragma unroll
  for (int r = 0; r < 16; ++r) rli[r] = __builtin_amdgcn_rcpf(li_l[crow(r, hi)]);
  float* Ow = Ob + (long)(wid * QBLK) * LDO;
#pragma unroll
  for (int r = 0; r < 16; ++r) { int orow = crow(r, hi);
#pragma unroll
    for (int d0 = 0; d0 < 4; ++d0) Ow[(long)orow * LDO + d0 * 32 + r32] = o[d0][r] * rli[r]; }
  __syncthreads();
#undef SLOAD
#undef SWRITE
#undef SWAIT
#undef RESC
}
#undef SBAR
}

template <int CTRL> __device__ __forceinline__ float dpp_mov(float v) { return __builtin_bit_cast(float, __builtin_amdgcn_update_dpp(0, __builtin_bit_cast(int, v), CTRL, 0xf, 0xf, true)); }
__device__ __forceinline__ float allreduce16(float v) { v += dpp_mov<0xB1>(v); v += dpp_mov<0x4E>(v); v += dpp_mov<0x141>(v); v += dpp_mov<0x140>(v); return v; }
constexpr int SCAN_TB = 32, SCAN_STEP_B = 6 * 64 * 4, SCAN_BUF_B = SCAN_TB * SCAN_STEP_B;
__device__ __forceinline__ void scan_unit(const Args& a, int b_loc, int head, int dir, int S, LAS unsigned char* lds, const int tid) {
    const int g = tid >> 4, c = tid & 15;
    unsigned char* ws = a.ws;
    const bf16_t* CV = (const bf16_t*)(ws + WS_CONV); const bf16_t* LO = (const bf16_t*)(ws + WS_LORA);
    float* O = (float*)(ws + (dir ? WS_OB : WS_OF));
    const long rowbase = (long)b_loc * S;
    const f32x4 ka = *(const f32x4*)(a.k_a + head * 64 + 4 * c);
    const int NB = S / SCAN_TB;
    u32x2 lr, lk, lv, lkk, lu, la;
#define SC_TOK(blk, st) (rowbase + (dir ? (S - 1 - ((blk) * SCAN_TB + (st))) : ((blk) * SCAN_TB + (st))))
#define SC_LOAD(blk) do { const long tk_ = SC_TOK(blk, g); const bf16_t* cv_ = CV + (tk_ * 16 + head) * 256 + 4 * c; const bf16_t* lo_ = LO + tk_ * 4096 + dir * 1024 + head * 64 + 4 * c; \
        lr = *(const u32x2*)(cv_); lk = *(const u32x2*)(cv_ + 64); lv = *(const u32x2*)(cv_ + 128); lkk = *(const u32x2*)(cv_ + 192); lu = *(const u32x2*)(lo_); la = *(const u32x2*)(lo_ + 2048); } while (0)
#define SC_UNP(w) ((f32x4){bf_lo((w).x), bf_hi((w).x), bf_lo((w).y), bf_hi((w).y)})
#define SC_WRITE(buf) do { const f32x4 r_ = SC_UNP(lr), k_ = SC_UNP(lk), v_ = SC_UNP(lv), kk_ = SC_UNP(lkk), u_ = SC_UNP(lu), a_ = SC_UNP(la); \
        LAS f32x4* p_ = (LAS f32x4*)(lds + (buf) * SCAN_BUF_B + g * SCAN_STEP_B) + c; \
        p_[0] = u_; p_[16] = kk_ * a_; p_[32] = k_ * (1.0f + (a_ - 1.0f) * ka); p_[48] = -kk_; p_[64] = r_; p_[80] = v_; } while (0)
    float s0[4] = {0.f, 0.f, 0.f, 0.f}, s1[4] = {0.f, 0.f, 0.f, 0.f};
    SC_LOAD(0); SC_WRITE(0); __syncthreads();
    for (int blk = 0; blk < NB; ++blk) {
        if (blk + 1 < NB) SC_LOAD(blk + 1);
        const LAS unsigned char* bp = lds + (blk & 1) * SCAN_BUF_B;
#pragma unroll 4
        for (int st = 0; st < SCAN_TB; ++st) {
            const LAS f32x4* p = (const LAS f32x4*)(bp + st * SCAN_STEP_B) + c;
            const f32x4 u = p[0], bb = p[16], kd = p[32], nk = p[48], rr = p[64];
            const f32x2 vv = *(const LAS f32x2*)(bp + st * SCAN_STEP_B + 5 * 256 + g * 8);
            float sa0 = s0[0] * nk[0], sa1 = s1[0] * nk[0];
#pragma unroll
            for (int i = 1; i < 4; ++i) { sa0 = fmaf(s0[i], nk[i], sa0); sa1 = fmaf(s1[i], nk[i], sa1); }
            sa0 = allreduce16(sa0); sa1 = allreduce16(sa1);
            float o0 = 0.f, o1 = 0.f;
#pragma unroll
            for (int i = 0; i < 4; ++i) {
                float t0 = fmaf(-s0[i], u[i], s0[i]); t0 = fmaf(sa0, bb[i], t0); t0 = fmaf(vv[0], kd[i], t0); s0[i] = t0; o0 = fmaf(t0, rr[i], o0);
                float t1 = fmaf(-s1[i], u[i], s1[i]); t1 = fmaf(sa1, bb[i], t1); t1 = fmaf(vv[1], kd[i], t1); s1[i] = t1; o1 = fmaf(t1, rr[i], o1);
            }
            o0 = allreduce16(o0); o1 = allreduce16(o1);
            if (c == 0) *(f32x2*)(O + SC_TOK(blk, st) * 1024 + head * 64 + 2 * g) = (f32x2){o0, o1};
        }
        if (blk + 1 < NB) SC_WRITE((blk + 1) & 1);
        __syncthreads();
    }
#undef SC_TOK
#undef SC_LOAD
#undef SC_UNP
#undef SC_WRITE
}

__device__ __forceinline__ void phase_post(const Args& a, int gw, int NGW, int lane) {
    unsigned char* ws = a.ws;
    const bf16_t* H = (const bf16_t*)(ws + WS_H); const float* AT = (const float*)(ws + WS_ATT);
    const float* OF = (const float*)(ws + WS_OF); const float* OB = (const float*)(ws + WS_OB);
    const bf16_t* CV = (const bf16_t*)(ws + WS_CONV); const float* BN = (const float*)(ws + WS_BONUS);
    bf16_t* OA = (bf16_t*)(ws + WS_OA); bf16_t* ORG = (bf16_t*)(ws + WS_ORG);
    const float d1 = wave_sum(a.lq1[lane] * a.lk1[lane]), d2 = wave_sum(a.lq2[lane] * a.lk2[lane]);
    const float lam = expf(d1) - expf(d2) + 0.2f;
    const f32x2 sg = ((const f32x2*)a.subln_g)[lane];
    for (int it = gw; it < TCH * 8; it += NGW) {
        const int t = it >> 3, h = it & 7;
        const f32x2 o1 = *(const f32x2*)(AT + (size_t)t * 2048 + (h * 2) * 128 + 2 * lane), o2 = *(const f32x2*)(AT + (size_t)t * 2048 + (h * 2 + 1) * 128 + 2 * lane);
        const float x0 = o1.x - lam * o2.x, x1 = o1.y - lam * o2.y;
        const float rstd = 1.0f / sqrtf(wave_sum(x0 * x0 + x1 * x1) * (1.0f / 128.0f) + 1e-5f);
        const unsigned gw_ = *(const unsigned*)(H + (size_t)t * PIN + C_GA + h * 128 + 2 * lane);
        const float g0 = bf_lo(gw_), g1 = bf_hi(gw_);
        const float y0 = x0 * rstd * sg.x * 0.8f * g0 * fsigmoid(g0), y1 = x1 * rstd * sg.y * 0.8f * g1 * fsigmoid(g1);
        *(unsigned*)(OA + (size_t)t * DM + h * 128 + 2 * lane) = cvt_pk_bf16(y0, y1);
    }
    for (int it = gw; it < TCH * 16; it += NGW) {
        const int t = it >> 4, hd = it & 15; const int hc = hd * 64 + lane;
        const float o = OF[(size_t)t * DM + hc] + OB[(size_t)t * DM + hc];
        const float mu = wave_sum(o) * (1.0f / 64.0f); const float d = o - mu;
        const float var = wave_sum(d * d) * (1.0f / 64.0f);
        const float v = bf1(CV[((size_t)t * 16 + hd) * 256 + 128 + lane]);
        const float on = d * (1.0f / sqrtf(var + 64e-5f)) * a.lnx_g[hc] + a.lnx_b[hc] + BN[t * 16 + hd] * v;
        const float gr = bf1(H[(size_t)t * PIN + C_GR + hc]);
        const unsigned w = cvt_pk_bf16(on * gr * fsigmoid(gr), 0.f);
        ORG[(size_t)t * DM + hc] = (bf16_t)(w & 0xffffu);
    }
}

constexpr int N_PHASES = 1 + 6 * NCHUNK + 1;
#if defined(__HIP_DEVICE_COMPILE__)
#define LOAD_ARGS() typedef const __attribute__((address_space(4))) Args* CArgsP; \
        CArgsP ap = (CArgsP)__builtin_amdgcn_kernarg_segment_ptr(); \
        asm volatile("" : "+s"(ap)); \
        Args a; \
        a.x_p = ap->x_p; a.x_s = ap->x_s; a.norm_g = ap->norm_g; a.w_in = ap->w_in; a.conv = ap->conv; a.lq1 = ap->lq1; a.lk1 = ap->lk1; a.lq2 = ap->lq2; a.lk2 = ap->lk2; \
        a.subln_g = ap->subln_g; a.wlu = ap->wlu; a.w0 = ap->w0; a.alu = ap->alu; a.a0 = ap->a0; a.k_k = ap->k_k; a.k_a = ap->k_a; a.r_k = ap->r_k; a.lnx_g = ap->lnx_g; a.lnx_b = ap->lnx_b; \
        a.w_oa = ap->w_oa; a.w_or = ap->w_or; a.w_out = ap->w_out; a.final_g = ap->final_g; a.out = ap->out; a.ws = ap->ws; a.ph_lo = 0; a.ph_hi = 0; \
        unsigned char* ws = a.ws; unsigned* ctl = (unsigned*)(ws + WS_CTL); bf16_t* XN = (bf16_t*)(ws + WS_XN); bf16_t* H = (bf16_t*)(ws + WS_H); (void)ctl; (void)XN; (void)H;
#else
#define LOAD_ARGS() Args a = a_in; unsigned char* ws = a.ws; unsigned* ctl = (unsigned*)(ws + WS_CTL); bf16_t* XN = (bf16_t*)(ws + WS_XN); bf16_t* H = (bf16_t*)(ws + WS_H); (void)ctl; (void)XN; (void)H;
#endif
__global__ void __launch_bounds__(NTHR, 2) mega_fwd(Args a_in) {
    extern __shared__ __attribute__((aligned(16))) unsigned char lds_raw[];
    LAS unsigned char* lds = (LAS unsigned char*)lds_raw;
    cg::grid_group grid = cg::this_grid();
    const int G = gridDim.x;
    volatile LAS unsigned* misc = (volatile LAS unsigned*)(lds + LDS_BYTES - 64);
#ifndef PH_MASK
#define PH_MASK 0xff
#endif
    const int ph_lo = a_in.ph_lo, ph_hi = a_in.ph_hi;
    const int wave0 = __builtin_amdgcn_readfirstlane(threadIdx.x >> 6);
    for (int p = ph_lo; p < ph_hi; ++p) {
        int wave = wave0; asm volatile("" : "+s"(wave));
        int tid = wave * 64 + (int)__builtin_amdgcn_mbcnt_hi(~0u, __builtin_amdgcn_mbcnt_lo(~0u, 0u)); asm volatile("" : "+v"(tid));
        const int lane = tid & 63;
        const int gw = blockIdx.x * NWAVES + wave, NGW = G * NWAVES;
        if (p == 0) { if (!(PH_MASK & 1)) continue; LOAD_ARGS();
            if (blockIdx.x == 0 && tid < 64) ctl[tid] = 0u;
            phase_weights(a, lds, gw, NGW, lane, wave);
            phase_xn(a.x_p, a.norm_g, XN, TCH, gw, NGW, lane);
        } else if (p == N_PHASES - 1) { if (!(PH_MASK & 128)) continue; LOAD_ARGS();
            phase_final(a.out, a.final_g, NTOK, gw, NGW, lane);
        } else {
            const int ch = (p - 1) / 6, sub = (p - 1) % 6;
            const int S = ch < 4 ? 2048 : 4096, nb = TCH / S;
            const size_t grow = (size_t)ch * TCH;
            if (sub == 0) { if (!(PH_MASK & 2)) continue; LOAD_ARGS();
                pg8::Gemm g{XN, (const bf16_t*)(ws + WS_WIN), TCH, PIN, DM, DM, DM}; pg8::StaticOrder So; So.init(TCH, PIN, G, (int)blockIdx.x);
                EpiIn E{H}; pg8::gemm_phase(lds, g, So, E, tid);
            } else if (sub == 1) { if (!(PH_MASK & 4)) continue; LOAD_ARGS();
#ifndef NO_PREP
                phase_prep(a, S, gw, NGW, lane);
#endif
                pg8::Gemm g{H + C_WL, (const bf16_t*)(ws + WS_WLORA), TCH, 4096, 256, PIN, 256}; pg8::StaticOrder So; So.init(TCH, 4096, G, (int)blockIdx.x);
                EpiLora E{(bf16_t*)(ws + WS_LORA), a.w0, a.a0}; pg8::gemm_phase(lds, g, So, E, tid);
            } else if (sub == 2) { if (!(PH_MASK & 8)) continue; LOAD_ARGS();
                const int nscan = nb * 32, nqb = S / 256, natt = nb * 16 * nqb;
                for (;;) {
                    if (tid == 0) misc[0] = atomicAdd(ctl + ch, 1u);
                    __syncthreads(); const unsigned u = misc[0]; __syncthreads();
                    if (u >= (unsigned)(nscan + natt)) break;
                    if (u < (unsigned)nscan) { scan_unit(a, u >> 5, (u >> 1) & 15, u & 1, S, lds, tid); }
                    else { const int v = u - nscan, qb = v % nqb, hm = (v / nqb) & 15, b = v / (nqb * 16);
                        const size_t r0 = (size_t)b * S;
                        att::attn_body(H + (r0 + qb * 256) * PIN + C_Q + hm * 64, H + r0 * PIN + C_K + hm * 64, H + r0 * PIN + C_V + (hm >> 1) * 128,
                                       (float*)(ws + WS_ATT) + (r0 + qb * 256) * 2048 + hm * 128, S, (char*)lds_raw, tid); }
                }
            } else if (sub == 3) { if (!(PH_MASK & 16)) continue; LOAD_ARGS();
                phase_post(a, gw, NGW, lane);
            } else if (sub == 4) { if (!(PH_MASK & 32)) continue; LOAD_ARGS();
                { pg8::Gemm g{(const bf16_t*)(ws + WS_OA), (const bf16_t*)(ws + WS_WOA), TCH, DM, DM, DM, DM}; pg8::StaticOrder So; So.init(TCH, DM, G, (int)blockIdx.x);
                  EpiMa E{(float*)(ws + WS_ATT), H, C_GMA}; pg8::gemm_phase(lds, g, So, E, tid); }
                { pg8::Gemm g{(const bf16_t*)(ws + WS_ORG), (const bf16_t*)(ws + WS_WOR), TCH, DM, DM, DM, DM}; pg8::StaticOrder So; So.init(TCH, DM, G, (int)blockIdx.x);
                  EpiM E{(bf16_t*)(ws + WS_M), (const float*)(ws + WS_ATT), H, C_GMB}; pg8::gemm_phase(lds, g, So, E, tid); }
            } else { if (!(PH_MASK & 64)) continue; LOAD_ARGS();
                { pg8::Gemm g{(const bf16_t*)(ws + WS_M), (const bf16_t*)(ws + WS_WOUT), TCH, DM, DM, DM, DM}; pg8::StaticOrder So; So.init(TCH, DM, G, (int)blockIdx.x);
                  const float* xc = ch < 4 ? a.x_p + grow * DM : a.x_s + (grow - NTOK_P) * DM; EpiOut E{a.out + grow * DM, xc}; pg8::gemm_phase(lds, g, So, E, tid); }
                if (ch + 1 < NCHUNK) { const size_t gn = grow + TCH; phase_xn(ch + 1 < 4 ? a.x_p + gn * DM : a.x_s + (gn - NTOK_P) * DM, a.norm_g, XN, TCH, gw, NGW, lane); }
            }
        }
        if (p + 1 < ph_hi) grid.sync();
    }
}

extern "C" void kernel_launch(void* const* d_in, const int* in_sizes, int n_in, void* d_out, int out_size, void* d_ws, size_t ws_size, hipStream_t stream) {
    static int grid = 0;
    if (grid == 0) {
        if (n_in != 23 || ws_size < WS_END) { fprintf(stderr, "kernel_launch: unexpected n_in %d / ws %zu\n", n_in, ws_size); grid = -1; return; }
        int dev = 0, cus = 0, per_cu = 0;
        hipGetDevice(&dev); hipDeviceGetAttribute(&cus, hipDeviceAttributeMultiprocessorCount, dev);
        hipFuncSetAttribute((const void*)mega_fwd, hipFuncAttributeMaxDynamicSharedMemorySize, LDS_BYTES);
        hipOccupancyMaxActiveBlocksPerMultiprocessor(&per_cu, (const void*)mega_fwd, NTHR, LDS_BYTES);
        if (per_cu < 1) { fprintf(stderr, "kernel_launch: occupancy query says %d\n", per_cu); per_cu = 1; }
        grid = cus * 1;
    }
    if (grid < 0) return;
    Args a{};
    const float** f = (const float**)&a;
    for (int i = 0; i < 23; ++i) f[i] = (const float*)d_in[i];
    a.out = (float*)d_out; a.ws = (unsigned char*)d_ws; a.ph_lo = 0; a.ph_hi = N_PHASES;
    void* args[] = {&a};
    hipError_t e = hipLaunchCooperativeKernel((const void*)mega_fwd, dim3(grid), dim3(NTHR), args, LDS_BYTES, stream);
    if (e != hipSuccess) fprintf(stderr, "cooperative launch failed: %s (grid %d)\n", hipGetErrorString(e), grid);
}
```

```cpp
#include <hip/hip_runtime.h>
#include <hip/hip_bf16.h>
#include <hip/hip_cooperative_groups.h>
#include <cstdio>
#include <cstdint>
namespace cg = cooperative_groups;

constexpr int DM = 1024, PIN = 10496, TCH = 16384, NCHUNK = 6;
constexpr int NTOK_P = 32 * 2048, NTOK_S = 8 * 4096, NTOK = NTOK_P + NTOK_S;
constexpr int C_Q = 0, C_K = 1024, C_V = 2048, C_GA = 3072, C_RKV = 4096, C_GR = 7168, C_WL = 8192, C_GMA = 8448, C_GMB = 9472;
constexpr size_t MiB = 1u << 20;
constexpr size_t WS_CTL = 0;
constexpr size_t WS_WIN = 1 * MiB;
constexpr size_t WS_WOA = 22 * MiB, WS_WOR = 24 * MiB, WS_WOUT = 26 * MiB, WS_WLORA = 28 * MiB;
constexpr size_t WS_ROPE = 30 * MiB;
constexpr size_t WS_BONUS = 31 * MiB;
constexpr size_t WS_XN = 32 * MiB;
constexpr size_t WS_H = 64 * MiB;
constexpr size_t WS_CONV = 392 * MiB;
constexpr size_t WS_LORA = 520 * MiB;
constexpr size_t WS_ATT = 648 * MiB;
constexpr size_t WS_OF = 776 * MiB, WS_OB = 840 * MiB;
constexpr size_t WS_OA = 904 * MiB, WS_ORG = 936 * MiB;
constexpr size_t WS_M = 968 * MiB;
constexpr size_t WS_LW = 1000 * MiB;
constexpr size_t WS_XN1 = 808 * MiB;
constexpr size_t WS_END = 1008 * MiB;

#define LAS __attribute__((address_space(3)))
typedef unsigned short bf16_t;
typedef short bf16x8 __attribute__((ext_vector_type(8)));
typedef short s16x4 __attribute__((ext_vector_type(4)));
typedef float f32x4 __attribute__((ext_vector_type(4)));
typedef float f32x2 __attribute__((ext_vector_type(2)));
typedef float f32x8 __attribute__((ext_vector_type(8)));
typedef float f32x16 __attribute__((ext_vector_type(16)));
typedef unsigned u32x4 __attribute__((ext_vector_type(4)));
typedef unsigned u32x2 __attribute__((ext_vector_type(2)));

typedef __bf16 bf16x2_t __attribute__((ext_vector_type(2)));
__device__ __forceinline__ unsigned cvt_pk_bf16(float lo, float hi) { f32x2 v = {lo, hi}; bf16x2_t b = __builtin_convertvector(v, bf16x2_t); return __builtin_bit_cast(unsigned, b); }
__device__ __forceinline__ float bf_lo(unsigned w) { return __uint_as_float(w << 16); }
__device__ __forceinline__ float bf_hi(unsigned w) { return __uint_as_float(w & 0xffff0000u); }
__device__ __forceinline__ float bf1(bf16_t h) { return __uint_as_float(((unsigned)h) << 16); }
__device__ __forceinline__ float fsigmoid(float x) { return __builtin_amdgcn_rcpf(1.0f + __builtin_amdgcn_exp2f(-1.4426950408889634f * x)); }
__device__ __forceinline__ float ftanh(float x) { float t = __builtin_amdgcn_exp2f(2.8853900817779268f * x); return 1.0f - 2.0f * __builtin_amdgcn_rcpf(t + 1.0f); }
template <int CTRL> __device__ __forceinline__ float dpp_mov(float v) { return __builtin_bit_cast(float, __builtin_amdgcn_update_dpp(0, __builtin_bit_cast(int, v), CTRL, 0xf, 0xf, true)); }
__device__ __forceinline__ float allreduce16(float v) { v += dpp_mov<0xB1>(v); v += dpp_mov<0x4E>(v); v += dpp_mov<0x141>(v); v += dpp_mov<0x140>(v); return v; }
__device__ __forceinline__ float wave_sum(float v) {
    v = allreduce16(v);
    const int iv = __builtin_bit_cast(int, v);
    const float a = __builtin_bit_cast(float, __builtin_amdgcn_readlane(iv, 0)), b = __builtin_bit_cast(float, __builtin_amdgcn_readlane(iv, 16));
    const float c = __builtin_bit_cast(float, __builtin_amdgcn_readlane(iv, 32)), d = __builtin_bit_cast(float, __builtin_amdgcn_readlane(iv, 48));
    return (a + b) + (c + d);
}

namespace pg8 {
constexpr int BM = 256, BK = 64, HALF = 128, HTB = HALF * BK * 2, STAGE_BYTES = 8 * HTB, NXCD = 8, WGM = 4;
__host__ __device__ __forceinline__ int lds_byte(int r, int c) { const int st = (r >> 4) * 2 + (c >> 5), rr = r & 15, cc = c & 31, ob = rr * 64 + cc * 2; return st * 1024 + (ob ^ (((ob >> 9) & 1) << 5)); }
__host__ __device__ __forceinline__ void stage_rc(int b, int& R, int& C) { const int st = b / 1024, sb = b % 1024, swz = sb ^ (((sb >> 9) & 1) << 5); R = (st >> 1) * 16 + swz / 64; C = (st & 1) * 32 + (swz % 64) / 2; }
__host__ __device__ __forceinline__ int perm32(int rho) { const int n = rho >> 4, i = rho & 15; return 8 * (i >> 2) + 4 * n + (i & 3); }
struct Unit { int pm, pn; };
struct Gemm { const bf16_t* A; const bf16_t* Bt; int M, N, K, lda, ldb; };
struct StaticOrder {
    int nM, nN, nwg, G, c, reps;
    __device__ void init(int M, int N, int G_, int c_, int reps_ = 1) { nM = M / BM; nN = N / BM; nwg = nM * nN; G = G_; c = c_; reps = reps_; }
    __device__ bool next(int i, Unit& u) const {
        const long L = (long)i * G + c; if (L >= (long)nwg * reps) return false;
        int wgid = (int)(L % nwg); { const int q = nwg / NXCD, r = nwg % NXCD, xcd = wgid % NXCD, off = wgid / NXCD; wgid = (xcd < r ? xcd * (q + 1) : r * (q + 1) + (xcd - r) * q) + off; }
        const int nig = WGM * nN, gid = wgid / nig, fm = gid * WGM, gsz = (nM - fm) < WGM ? (nM - fm) : WGM;
        u.pm = fm + ((wgid % nig) % gsz); u.pn = (wgid % nig) / gsz; return true;
    }
};
template <class F> __device__ __forceinline__ void epi_foreach(const f32x4 (&acc)[2][2][4][2], const Unit& u, int wr, int wc, int fr, int fq, const F& f) {
    const int row0 = u.pm * BM + wr * 64 + fr, col0 = u.pn * BM + wc * 32 + 8 * fq;
#pragma unroll
    for (int ai = 0; ai < 2; ++ai)
#pragma unroll
        for (int m = 0; m < 4; ++m)
#pragma unroll
            for (int bj = 0; bj < 2; ++bj) { f(row0 + ai * HALF + m * 16, col0 + bj * HALF, acc[ai][bj][m][0], acc[ai][bj][m][1]); if ((m & 1) && bj) asm volatile("" ::: "memory"); }
}

template <class F> __device__ __forceinline__ void acc_foreach(f32x4 (&acc)[2][2][4][2], const Unit& u, int wr, int wc, int fr, int fq, const F& f) {
    const int row0 = u.pm * BM + wr * 64 + fr, col0 = u.pn * BM + wc * 32 + 8 * fq;
#pragma unroll
    for (int ai = 0; ai < 2; ++ai)
#pragma unroll
        for (int m = 0; m < 4; ++m)
#pragma unroll
            for (int bj = 0; bj < 2; ++bj) { f(row0 + ai * HALF + m * 16, col0 + bj * HALF, acc[ai][bj][m][0], acc[ai][bj][m][1]); if ((m & 1) && bj) asm volatile("" ::: "memory"); }
}
template <int LDA, int LDB, class Epi>
__device__ __forceinline__ void gemm_phase(LAS unsigned char* lds, const Gemm g, const StaticOrder& S, const Epi& E, const int tid) {
    const int wid = __builtin_amdgcn_readfirstlane(tid >> 6), lane = tid & 63, wr = wid >> 2, wc = wid & 3, fr = lane & 15, fq = lane >> 4;
    const int K = g.K, nt = K / BK;
    unsigned vofA[2], vofB[2];
    { int R, C; stage_rc(tid * 16, R, C); const int Rb = (R & ~31) + perm32(R & 31);
      vofA[0] = (unsigned)(R * LDA + C) * 2u; vofB[0] = (unsigned)(Rb * LDB + C) * 2u; vofA[1] = vofA[0] + 64u * LDA * 2u; vofB[1] = vofB[0] + 64u * LDB * 2u; }
    constexpr size_t kstep = (size_t)(BK * 2);
    constexpr size_t hstepA = (size_t)HALF * LDA * 2, hstepB = (size_t)HALF * LDB * 2;
    constexpr size_t tstepA = 2 * hstepA, tstepB = 2 * hstepB;
    const unsigned ldsw = (unsigned)wid * 1024u;
#define PG8_SA(b, h) (((b) * 2 + (h)) * HTB)
#define PG8_SB(b, h) ((4 + (b) * 2 + (h)) * HTB)
#define PG8_STAGE(bufoff, gbase, voff) do { _Pragma("unroll") for (int _i = 0; _i < 2; ++_i) \
        __builtin_amdgcn_global_load_lds((const unsigned*)((const char*)(gbase) + vof##voff[_i]), (LAS unsigned*)(lds + (bufoff) + ldsw + _i * 8192), 16, 0, 0); } while (0)
#define PG8_LDA(dst, b, h) do { _Pragma("unroll") for (int m = 0; m < 4; ++m) _Pragma("unroll") for (int k = 0; k < 2; ++k) dst[m][k] = *(const LAS bf16x8*)(lds + PG8_SA(b, h) + aoff + m * 2048 + k * 1024); } while (0)
#define PG8_LDB(dst, b, h) do { _Pragma("unroll") for (int n = 0; n < 2; ++n) _Pragma("unroll") for (int k = 0; k < 2; ++k) dst[n][k] = *(const LAS bf16x8*)(lds + PG8_SB(b, h) + boff + n * 2048 + k * 1024); } while (0)
#define PG8_MMA(ai, bj, At, Bt) do { __builtin_amdgcn_s_setprio(1); _Pragma("unroll") for (int m = 0; m < 4; ++m) _Pragma("unroll") for (int n = 0; n < 2; ++n) _Pragma("unroll") for (int k = 0; k < 2; ++k) \
        acc[ai][bj][m][n] = __builtin_amdgcn_mfma_f32_16x16x32_bf16(Bt[n][k], At[m][k], acc[ai][bj][m][n], 0, 0, 0); __builtin_amdgcn_s_setprio(0); } while (0)
#define PG8_WAIT_V(n) asm volatile("s_waitcnt vmcnt(" #n ")" ::: "memory")
#define PG8_WAIT_L(n) asm volatile("s_waitcnt lgkmcnt(" #n ")" ::: "memory")
#define PG8_BAR __builtin_amdgcn_s_barrier()
#define PG8_SCHED __builtin_amdgcn_sched_barrier(0)
    Unit cur, nxt; int ui = 0;
    if (!S.next(0, cur)) return;
    f32x4 acc[2][2][4][2];
#pragma unroll
    for (int a = 0; a < 2; ++a)
#pragma unroll
        for (int b = 0; b < 2; ++b)
#pragma unroll
            for (int m = 0; m < 4; ++m)
#pragma unroll
                for (int n = 0; n < 2; ++n) acc[a][b][m][n] = (f32x4){0.f, 0.f, 0.f, 0.f};
    bf16x8 At[4][2], B0[2][2], B1[2][2];
    const char* cA = (const char*)g.A + (size_t)cur.pm * tstepA; const char* cB = (const char*)g.Bt + (size_t)cur.pn * tstepB;
#define PG8_LAUNDER asm volatile("" : "+v"(vofA[0]), "+v"(vofA[1]), "+v"(vofB[0]), "+v"(vofB[1]))
    PG8_LAUNDER; PG8_STAGE(PG8_SB(0, 0), cB, B); PG8_LAUNDER; PG8_STAGE(PG8_SB(0, 1), cB + hstepB, B); PG8_LAUNDER; PG8_STAGE(PG8_SA(0, 0), cA, A); PG8_LAUNDER; PG8_STAGE(PG8_SA(0, 1), cA + hstepA, A);
    if (wr == 1) PG8_BAR;
    PG8_WAIT_V(2); PG8_BAR;
    PG8_LAUNDER; PG8_STAGE(PG8_SB(1, 0), cB + kstep, B); PG8_LAUNDER; PG8_STAGE(PG8_SA(1, 0), cA + kstep, A); PG8_LAUNDER; PG8_STAGE(PG8_SB(1, 1), cB + hstepB + kstep, B);
    PG8_WAIT_V(6); PG8_BAR; PG8_LAUNDER;
    for (;;) {
        unsigned zq_ = 0u; asm volatile("" : "+v"(zq_)); const int lq_ = (int)__builtin_amdgcn_mbcnt_hi(~0u, __builtin_amdgcn_mbcnt_lo(~0u, zq_));
        const int aoff = lds_byte(wr * 64 + (lq_ & 15), (lq_ >> 4) * 8), boff = lds_byte(wc * 32 + (lq_ & 15), (lq_ >> 4) * 8);
        const bool has_next = S.next(ui + 1, nxt);
        const char* nA = has_next ? (const char*)g.A + (size_t)nxt.pm * tstepA : cA; const char* nB = has_next ? (const char*)g.Bt + (size_t)nxt.pn * tstepB : cB;
        for (int half = 0; half < (Epi::HAS_MID ? 2 : 1); ++half) {
        if constexpr (Epi::HAS_MID) if (half == 1) { unsigned zm_ = 0u; asm volatile("" : "+v"(zm_)); const int lm_ = (int)__builtin_amdgcn_mbcnt_hi(~0u, __builtin_amdgcn_mbcnt_lo(~0u, zm_)); E.mid(acc, cur, wr, wc, lm_ & 15, lm_ >> 4); }
        const int t_lo = Epi::HAS_MID ? half * (nt / 2) : 0, t_hi = Epi::HAS_MID ? (half + 1) * (nt / 2) : nt;
        for (int t = t_lo; t < t_hi; t += 2) {
            const bool last = (t == nt - 2);
            const char* a1 = cA + (size_t)(t + 1) * kstep;
            const char* a2 = last ? nA : cA + (size_t)(t + 2) * kstep; const char* b2 = last ? nB : cB + (size_t)(t + 2) * kstep;
            const char* a3 = a2 + kstep; const char* b3 = b2 + kstep;
            PG8_LDB(B0, 0, 0); PG8_LDB(B1, 0, 1); PG8_SCHED; PG8_LDA(At, 0, 0); PG8_STAGE(PG8_SA(1, 1), a1 + hstepA, A);
            PG8_WAIT_V(8); PG8_WAIT_L(0); PG8_BAR; PG8_MMA(0, 0, At, B0); PG8_MMA(0, 1, At, B1); PG8_BAR; PG8_SCHED;
            PG8_LDA(At, 0, 1); PG8_STAGE(PG8_SB(0, 0), b2, B); PG8_STAGE(PG8_SB(0, 1), b2 + hstepB, B); PG8_STAGE(PG8_SA(0, 0), a2, A);
            PG8_WAIT_V(8); PG8_WAIT_L(0); PG8_BAR; PG8_MMA(1, 0, At, B0); PG8_MMA(1, 1, At, B1); PG8_BAR; PG8_SCHED;
            PG8_LDB(B0, 1, 0); PG8_LDB(B1, 1, 1); PG8_SCHED; PG8_LDA(At, 1, 0); PG8_STAGE(PG8_SA(0, 1), a2 + hstepA, A);
            PG8_WAIT_V(8); PG8_WAIT_L(0); PG8_BAR; PG8_MMA(0, 0, At, B0); PG8_MMA(0, 1, At, B1); PG8_BAR; PG8_SCHED;
            PG8_LDA(At, 1, 1); PG8_STAGE(PG8_SB(1, 0), b3, B); PG8_STAGE(PG8_SB(1, 1), b3 + hstepB, B); PG8_STAGE(PG8_SA(1, 0), a3, A);
            PG8_WAIT_V(8); PG8_WAIT_L(0); PG8_BAR; PG8_MMA(1, 0, At, B0); PG8_MMA(1, 1, At, B1); PG8_BAR; PG8_SCHED;
        }
        }
        if (wr == 0) PG8_BAR;
        { unsigned z_ = 0u; asm volatile("" : "+v"(z_)); const int ln_ = (int)__builtin_amdgcn_mbcnt_hi(~0u, __builtin_amdgcn_mbcnt_lo(~0u, z_)); E(acc, cur, wr, wc, ln_ & 15, ln_ >> 4); }
        if (!has_next) break;
#pragma unroll
        for (int a = 0; a < 2; ++a)
#pragma unroll
            for (int b = 0; b < 2; ++b)
#pragma unroll
                for (int m = 0; m < 4; ++m)
#pragma unroll
                    for (int n = 0; n < 2; ++n) acc[a][b][m][n] = (f32x4){0.f, 0.f, 0.f, 0.f};
        cur = nxt; cA = nA; cB = nB; ++ui;
        if (wr == 1) PG8_BAR;
    }
    PG8_WAIT_V(0);
    PG8_BAR;
#undef PG8_SA
#undef PG8_SB
#undef PG8_STAGE
#undef PG8_LDA
#undef PG8_LDB
#undef PG8_MMA
#undef PG8_WAIT_V
#undef PG8_WAIT_L
#undef PG8_BAR
#undef PG8_SCHED
}
}

__device__ __forceinline__ u32x4 pack8(f32x4 v0, f32x4 v1) { u32x4 w; w.x = cvt_pk_bf16(v0[0], v0[1]); w.y = cvt_pk_bf16(v0[2], v0[3]); w.z = cvt_pk_bf16(v1[0], v1[1]); w.w = cvt_pk_bf16(v1[2], v1[3]); return w; }
__device__ __forceinline__ void unpack8(u32x4 w, float* f) { f[0] = bf_lo(w.x); f[1] = bf_hi(w.x); f[2] = bf_lo(w.y); f[3] = bf_hi(w.y); f[4] = bf_lo(w.z); f[5] = bf_hi(w.z); f[6] = bf_lo(w.w); f[7] = bf_hi(w.w); }

struct EpiIn {
    static constexpr bool HAS_MID = false;
    bf16_t* H; bf16_t* LW; const f32x4* RT; int smask;
    __device__ __forceinline__ void operator()(const f32x4 (&acc)[2][2][4][2], const pg8::Unit& u, int wr, int wc, int fr, int fq) const {
        const bool lt = (u.pn == C_WL / 256), qk = (u.pn < 8);
        bf16_t* base = lt ? LW - C_WL : H; const size_t pitch = lt ? 256 : PIN;
        const f32x4* rt = RT; const int sm = smask;
        pg8::epi_foreach(acc, u, wr, wc, fr, fq, [&](int row, int col, f32x4 v0, f32x4 v1) {
            if (lt && col < C_WL + 128) {
#pragma unroll
                for (int i = 0; i < 4; ++i) { v0[i] = ftanh(v0[i]); v1[i] = ftanh(v1[i]); }
            }
            if (qk && (col & 63) < 16) {
                const f32x4 c0 = rt[(row & sm) * 4 + ((col >> 3) & 1) * 2], c1 = rt[(row & sm) * 4 + ((col >> 3) & 1) * 2 + 1];
                const f32x4 x1 = v0, x2 = v1;
                v0 = (f32x4){x1[0] * c0[0] - x2[0] * c0[1], x1[1] * c0[2] - x2[1] * c0[3], x1[2] * c1[0] - x2[2] * c1[1], x1[3] * c1[2] - x2[3] * c1[3]};
                v1 = (f32x4){x2[0] * c0[0] + x1[0] * c0[1], x2[1] * c0[2] + x1[1] * c0[3], x2[2] * c1[0] + x1[2] * c1[1], x2[3] * c1[2] + x1[3] * c1[3]};
            }
            __builtin_nontemporal_store(pack8(v0, v1), (u32x4*)(base + (size_t)row * pitch + col)); });
    }
};
struct EpiLora {
    static constexpr bool HAS_MID = false;
    bf16_t* O; const float* w0; const float* a0;
    __device__ __forceinline__ void operator()(const f32x4 (&acc)[2][2][4][2], const pg8::Unit& u, int wr, int wc, int fr, int fq) const {
        bf16_t* Oo = O; const bool isw = (u.pn < 8); const float* bias = isw ? w0 : a0;
        pg8::epi_foreach(acc, u, wr, wc, fr, fq, [&](int row, int col, f32x4 v0, f32x4 v1) {
            const int bc = col & 2047;
            const f32x4 b0 = *(const f32x4*)(bias + bc), b1 = *(const f32x4*)(bias + bc + 4);
#pragma unroll
            for (int i = 0; i < 4; ++i) {
                float z0 = v0[i] + b0[i], z1 = v1[i] + b1[i];
                if (isw) { const float e0 = 0.6065306597126334f * fsigmoid(z0), e1 = 0.6065306597126334f * fsigmoid(z1);
                    v0[i] = 1.0f - __builtin_amdgcn_exp2f(-1.4426950408889634f * e0); v1[i] = 1.0f - __builtin_amdgcn_exp2f(-1.4426950408889634f * e1); }
                else { v0[i] = fsigmoid(z0); v1[i] = fsigmoid(z1); }
            }
            *(u32x4*)(Oo + (size_t)row * 4096 + col) = pack8(v0, v1); });
    }
};
struct EpiMa {
    static constexpr bool HAS_MID = false;
    float* MA; const bf16_t* H; int gcol;
    __device__ __forceinline__ void operator()(const f32x4 (&acc)[2][2][4][2], const pg8::Unit& u, int wr, int wc, int fr, int fq) const {
        float* Mm = MA; const bf16_t* Hh = H; const int gc = gcol;
        pg8::epi_foreach(acc, u, wr, wc, fr, fq, [&](int row, int col, f32x4 v0, f32x4 v1) {
            float gt[8]; unpack8(*(const u32x4*)(Hh + (size_t)row * PIN + gc + col), gt);
#pragma unroll
            for (int i = 0; i < 4; ++i) { v0[i] *= fsigmoid(gt[i]); v1[i] *= fsigmoid(gt[4 + i]); }
            float* p = Mm + (size_t)row * DM + col; *(f32x4*)p = v0; *(f32x4*)(p + 4) = v1; });
    }
};
struct EpiM {
    static constexpr bool HAS_MID = false;
    bf16_t* M; const float* MA; const bf16_t* H; int gcol;
    __device__ __forceinline__ void operator()(const f32x4 (&acc)[2][2][4][2], const pg8::Unit& u, int wr, int wc, int fr, int fq) const {
        bf16_t* Mo = M; const float* Mm = MA; const bf16_t* Hh = H; const int gc = gcol;
        pg8::epi_foreach(acc, u, wr, wc, fr, fq, [&](int row, int col, f32x4 v0, f32x4 v1) {
            float gt[8]; unpack8(*(const u32x4*)(Hh + (size_t)row * PIN + gc + col), gt);
            const float* p = Mm + (size_t)row * DM + col; const f32x4 m0 = *(const f32x4*)p, m1 = *(const f32x4*)(p + 4);
#pragma unroll
            for (int i = 0; i < 4; ++i) { v0[i] = m0[i] + v0[i] * fsigmoid(gt[i]); v1[i] = m1[i] + v1[i] * fsigmoid(gt[4 + i]); }
            *(u32x4*)(Mo + (size_t)row * DM + col) = pack8(v0, v1); });
    }
};
struct EpiMix {
    static constexpr bool HAS_MID = true;
    bf16_t* M; const bf16_t* H;
    __device__ __forceinline__ void mid(f32x4 (&acc)[2][2][4][2], const pg8::Unit& u, int wr, int wc, int fr, int fq) const {
        const bf16_t* Hh = H;
        pg8::acc_foreach(acc, u, wr, wc, fr, fq, [&](int row, int col, f32x4& v0, f32x4& v1) {
            float ga[8], gb[8]; unpack8(*(const u32x4*)(Hh + (size_t)row * PIN + C_GMA + col), ga); unpack8(*(const u32x4*)(Hh + (size_t)row * PIN + C_GMB + col), gb);
#pragma unroll
            for (int i = 0; i < 4; ++i) {
                v0[i] *= (1.0f + __builtin_amdgcn_exp2f(-1.4426950408889634f * gb[i])) * __builtin_amdgcn_rcpf(1.0f + __builtin_amdgcn_exp2f(-1.4426950408889634f * ga[i]));
                v1[i] *= (1.0f + __builtin_amdgcn_exp2f(-1.4426950408889634f * gb[4 + i])) * __builtin_amdgcn_rcpf(1.0f + __builtin_amdgcn_exp2f(-1.4426950408889634f * ga[4 + i])); } });
    }
    __device__ __forceinline__ void operator()(const f32x4 (&acc)[2][2][4][2], const pg8::Unit& u, int wr, int wc, int fr, int fq) const {
        bf16_t* Mo = M; const bf16_t* Hh = H;
        pg8::epi_foreach(acc, u, wr, wc, fr, fq, [&](int row, int col, f32x4 v0, f32x4 v1) {
            float gb[8]; unpack8(*(const u32x4*)(Hh + (size_t)row * PIN + C_GMB + col), gb);
#pragma unroll
            for (int i = 0; i < 4; ++i) { v0[i] *= fsigmoid(gb[i]); v1[i] *= fsigmoid(gb[4 + i]); }
            *(u32x4*)(Mo + (size_t)row * DM + col) = pack8(v0, v1); });
    }
};
struct EpiOut {
    static constexpr bool HAS_MID = false;
    float* out; const float* x;
    __device__ __forceinline__ void operator()(const f32x4 (&acc)[2][2][4][2], const pg8::Unit& u, int wr, int wc, int fr, int fq) const {
        float* oo = out; const float* xx = x;
        pg8::epi_foreach(acc, u, wr, wc, fr, fq, [&](int row, int col, f32x4 v0, f32x4 v1) {
            const size_t off = (size_t)row * DM + col;
            const f32x4 x0 = __builtin_nontemporal_load((const f32x4*)(xx + off)), x1 = __builtin_nontemporal_load((const f32x4*)(xx + off + 4));
            *(f32x4*)(oo + off) = v0 + x0; *(f32x4*)(oo + off + 4) = v1 + x1; });
    }
};

struct Args {
    const float* x_p; const float* x_s; const float* norm_g; const float* w_in; const float* conv; const float* lq1; const float* lk1; const float* lq2; const float* lk2;
    const float* subln_g; const float* wlu; const float* w0; const float* alu; const float* a0; const float* k_k; const float* k_a; const float* r_k; const float* lnx_g; const float* lnx_b;
    const float* w_oa; const float* w_or; const float* w_out; const float* final_g;
    float* out; unsigned char* ws; int ph_lo, ph_hi;
};
constexpr int NWAVES = 8, NTHR = 512;
constexpr int LDS_BYTES = 147456;

__device__ __forceinline__ void p0_transpose_item(const float* W, int K, int N, bf16_t* WT, LAS float* scr, int item, int lane, const int ldwt, const int koff, const bool ropeperm = false) {
    const int nblk = N / 32, kb = item / nblk, nb = item % nblk, k0 = 64 * kb, n0 = 32 * nb;
    int nsrc = n0 + (lane & 31);
    if (ropeperm && nsrc < 2048 && (nsrc & 63) < 16) { const int d = nsrc & 15; nsrc = (nsrc & ~15) | ((d & 3) | (((d >> 2) & 1) << 3) | (((d >> 3) & 1) << 2)); }
#pragma unroll 8
    for (int i = 0; i < 32; ++i) { const int kk = 2 * i + (lane >> 5); scr[kk * 33 + (lane & 31)] = W[(size_t)(k0 + kk) * N + nsrc]; }
    asm volatile("s_waitcnt lgkmcnt(0)" ::: "memory");
    const int c = lane & 7;
#pragma unroll
    for (int j = 0; j < 4; ++j) { const int n = (lane >> 3) + 8 * j; const LAS float* s = scr + (8 * c) * 33 + n;
        u32x4 o; o.x = cvt_pk_bf16(s[0 * 33], s[1 * 33]); o.y = cvt_pk_bf16(s[2 * 33], s[3 * 33]); o.z = cvt_pk_bf16(s[4 * 33], s[5 * 33]); o.w = cvt_pk_bf16(s[6 * 33], s[7 * 33]);
        *(u32x4*)(WT + (size_t)(n0 + n) * ldwt + koff + k0 + 8 * c) = o; }
    asm volatile("s_waitcnt lgkmcnt(0)" ::: "memory");
}

__device__ __forceinline__ void phase_weights(const Args& a, LAS unsigned char* lds, int gw, int NGW, int lane, int wave) {
    unsigned char* ws = a.ws;
    LAS float* scr = (LAS float*)(lds + wave * 16384);
    constexpr int I_IN = (DM / 64) * (PIN / 32), I_SQ = (DM / 64) * (DM / 32);
    for (int it = gw; it < I_IN + 3 * I_SQ; it += NGW) {
        int r = it;
        if (r < I_IN) { p0_transpose_item(a.w_in, DM, PIN, (bf16_t*)(ws + WS_WIN), scr, r, lane, DM, 0, true); continue; } r -= I_IN;
        if (r < I_SQ) { p0_transpose_item(a.w_oa, DM, DM, (bf16_t*)(ws + WS_WOA), scr, r, lane, 2048, 0); continue; } r -= I_SQ;
        if (r < I_SQ) { p0_transpose_item(a.w_or, DM, DM, (bf16_t*)(ws + WS_WOA), scr, r, lane, 2048, 1024); continue; } r -= I_SQ;
        p0_transpose_item(a.w_out, DM, DM, (bf16_t*)(ws + WS_WOUT), scr, r, lane, DM, 0);
    }
    bf16_t* WL = (bf16_t*)(ws + WS_WLORA);
    for (int e = gw * 64 + lane; e < 4096 * 256; e += NGW * 64) {
        const int n = e >> 8, k = e & 255, kind = n >> 10, ch = n & 1023, j = k - 64 * kind;
        float v = 0.f;
        if (j >= 0 && j < 64) { const float* src = (kind < 2) ? a.wlu : a.alu; v = src[((size_t)(kind & 1) * 64 + j) * 1024 + ch]; }
        WL[e] = (bf16_t)(cvt_pk_bf16(v, 0.f) & 0xffffu);
    }
    f32x2* RT = (f32x2*)(ws + WS_ROPE);
    for (int e = gw * 64 + lane; e < 4096 * 8; e += NGW * 64) {
        const int pos = e >> 3, i = e & 7;
        const float inv = exp2f(-(float)i * (0.125f * 18.931568569324174f));
        const float ang = (float)pos * inv;
        const float n = rintf(ang * 0.15915494309189535f);
        float r = fmaf(-n, 6.28125f, ang); r = fmaf(-n, 1.9353071795864769e-3f, r);
        RT[e] = (f32x2){__cosf(r), __sinf(r)};
    }
}

__device__ __forceinline__ void phase_xn(const float* x, const float* g, bf16_t* XN, int nrows, int gw, int NGW, int lane) {
    f32x4 gv[4];
#pragma unroll
    for (int j = 0; j < 4; ++j) gv[j] = ((const f32x4*)g)[lane + 64 * j];
    for (int m = gw; m < nrows; m += NGW) {
        const f32x4* xr = (const f32x4*)(x + (size_t)m * DM) + lane;
        f32x4 v[4]; float s = 0.f;
#pragma unroll
        for (int j = 0; j < 4; ++j) { v[j] = __builtin_nontemporal_load(xr + 64 * j); s += (v[j].x * v[j].x + v[j].y * v[j].y) + (v[j].z * v[j].z + v[j].w * v[j].w); }
        const float rstd = 1.0f / sqrtf(wave_sum(s) * (1.f / DM) + 1e-6f);
        u32x2* o8 = (u32x2*)(XN + (size_t)m * DM) + lane;
#pragma unroll
        for (int j = 0; j < 4; ++j) { u32x2 w; w.x = cvt_pk_bf16(v[j].x * rstd * gv[j].x, v[j].y * rstd * gv[j].y); w.y = cvt_pk_bf16(v[j].z * rstd * gv[j].z, v[j].w * rstd * gv[j].w); o8[64 * j] = w; }
    }
}
__device__ __forceinline__ void phase_final(float* out, const float* g, int nrows, int gw, int NGW, int lane) {
    f32x4 gv[4];
#pragma unroll
    for (int j = 0; j < 4; ++j) gv[j] = ((const f32x4*)g)[lane + 64 * j];
    for (int m = gw; m < nrows; m += NGW) {
        f32x4* xr = (f32x4*)(out + (size_t)m * DM) + lane;
        f32x4 v[4]; float s = 0.f;
#pragma unroll
        for (int j = 0; j < 4; ++j) { v[j] = __builtin_nontemporal_load(xr + 64 * j); s += (v[j].x * v[j].x + v[j].y * v[j].y) + (v[j].z * v[j].z + v[j].w * v[j].w); }
        const float rstd = 1.0f / sqrtf(wave_sum(s) * (1.f / DM) + 1e-6f);
#pragma unroll
        for (int j = 0; j < 4; ++j) __builtin_nontemporal_store(v[j] * rstd * gv[j], xr + 64 * j);
    }
}

__device__ __forceinline__ f32x4 unp4(u32x2 w) { return (f32x4){bf_lo(w.x), bf_hi(w.x), bf_lo(w.y), bf_hi(w.y)}; }
__device__ __forceinline__ u32x2 pk4(f32x4 v) { u32x2 w; w.x = cvt_pk_bf16(v[0], v[1]); w.y = cvt_pk_bf16(v[2], v[3]); return w; }
__device__ __forceinline__ void phase_prep(const Args& a, int S, int gw, int NGW, int lane, const bool do_rope) {
    unsigned char* ws = a.ws;
    bf16_t* H = (bf16_t*)(ws + WS_H); bf16_t* CV = (bf16_t*)(ws + WS_CONV); float* BN = (float*)(ws + WS_BONUS);
    const f32x4* RT = (const f32x4*)(ws + WS_ROPE);
    if (do_rope)
    for (int it = gw * 64 + lane; it < TCH * 32; it += NGW * 64) {
        const int t = it >> 5, grp = it & 31, pos = t % S;
        bf16_t* p = H + (size_t)t * PIN + grp * 64;
        const u32x4 w1 = *(const u32x4*)p, w2 = *(const u32x4*)(p + 8);
        float x1[8], x2[8], y1[8], y2[8]; unpack8(w1, x1); unpack8(w2, x2);
#pragma unroll
        for (int j = 0; j < 4; ++j) { const f32x4 cs = RT[pos * 4 + j];
            y1[2 * j] = x1[2 * j] * cs[0] - x2[2 * j] * cs[1]; y2[2 * j] = x2[2 * j] * cs[0] + x1[2 * j] * cs[1];
            y1[2 * j + 1] = x1[2 * j + 1] * cs[2] - x2[2 * j + 1] * cs[3]; y2[2 * j + 1] = x2[2 * j + 1] * cs[2] + x1[2 * j + 1] * cs[3]; }
        *(u32x4*)p = pack8((f32x4){y1[0], y1[1], y1[2], y1[3]}, (f32x4){y1[4], y1[5], y1[6], y1[7]});
        *(u32x4*)(p + 8) = pack8((f32x4){y2[0], y2[1], y2[2], y2[3]}, (f32x4){y2[4], y2[5], y2[6], y2[7]});
    }
    {
        const int hd = 8 * (gw & 1) + (lane >> 3), c8 = 8 * (lane & 7), hc = hd * 64 + c8;
        f32x4 cw[3][3][2];
#pragma unroll
        for (int part = 0; part < 3; ++part)
#pragma unroll
            for (int i = 0; i < 3; ++i) { cw[part][i][0] = *(const f32x4*)(a.conv + i * 3072 + part * 1024 + hc); cw[part][i][1] = *(const f32x4*)(a.conv + i * 3072 + part * 1024 + hc + 4); }
        const f32x4 kw0 = *(const f32x4*)(a.k_k + hc), kw1 = *(const f32x4*)(a.k_k + hc + 4), rw0 = *(const f32x4*)(a.r_k + hc), rw1 = *(const f32x4*)(a.r_k + hc + 4);
        for (int t0 = gw >> 1; t0 < TCH; t0 += NGW) {
            u32x4 raw[2][3][3];
#pragma unroll
            for (int e = 0; e < 2; ++e) { const int t = t0 + e * (NGW >> 1); if (t >= TCH) continue;
                const int pos = t % S; const bool hasp = pos > 0, hasn = pos < S - 1;
                const bf16_t* hr = H + (size_t)t * PIN + C_RKV + hc;
#pragma unroll
                for (int part = 0; part < 3; ++part) {
                    raw[e][part][1] = *(const u32x4*)(hr + part * 1024);
                    raw[e][part][0] = hasp ? *(const u32x4*)(hr + part * 1024 - PIN) : (u32x4){0u, 0u, 0u, 0u};
                    raw[e][part][2] = hasn ? *(const u32x4*)(hr + part * 1024 + PIN) : (u32x4){0u, 0u, 0u, 0u}; } }
#pragma unroll
            for (int e = 0; e < 2; ++e) { const int t = t0 + e * (NGW >> 1); if (t >= TCH) continue;
                float rkv[3][8];
#pragma unroll
                for (int part = 0; part < 3; ++part) {
                    float xm[8], x0[8], xp[8]; unpack8(raw[e][part][0], xm); unpack8(raw[e][part][1], x0); unpack8(raw[e][part][2], xp);
#pragma unroll
                    for (int i = 0; i < 8; ++i) { const float w0 = cw[part][0][i >> 2][i & 3], w1 = cw[part][1][i >> 2][i & 3], w2 = cw[part][2][i >> 2][i & 3];
                        rkv[part][i] = fmaf(xp[i], w2, fmaf(xm[i], w0, x0[i] * w1)); }
                }
                float kk[8], ss = 0.f, bs = 0.f;
#pragma unroll
                for (int i = 0; i < 8; ++i) { kk[i] = rkv[1][i] * (i < 4 ? kw0[i] : kw1[i - 4]); ss = fmaf(kk[i], kk[i], ss); bs = fmaf(rkv[0][i] * rkv[1][i], (i < 4 ? rw0[i] : rw1[i - 4]), bs); }
                ss += dpp_mov<0xB1>(ss); ss += dpp_mov<0x4E>(ss); ss += dpp_mov<0x141>(ss);
                bs += dpp_mov<0xB1>(bs); bs += dpp_mov<0x4E>(bs); bs += dpp_mov<0x141>(bs);
                const float rn = 1.0f / sqrtf(ss + 1e-12f);
                bf16_t* o = CV + ((size_t)t * 16 + hd) * 256 + c8;
                *(u32x4*)o = pack8((f32x4){rkv[0][0], rkv[0][1], rkv[0][2], rkv[0][3]}, (f32x4){rkv[0][4], rkv[0][5], rkv[0][6], rkv[0][7]});
                *(u32x4*)(o + 64) = pack8((f32x4){rkv[1][0], rkv[1][1], rkv[1][2], rkv[1][3]}, (f32x4){rkv[1][4], rkv[1][5], rkv[1][6], rkv[1][7]});
                *(u32x4*)(o + 128) = pack8((f32x4){rkv[2][0], rkv[2][1], rkv[2][2], rkv[2][3]}, (f32x4){rkv[2][4], rkv[2][5], rkv[2][6], rkv[2][7]});
                *(u32x4*)(o + 192) = pack8((f32x4){kk[0] * rn, kk[1] * rn, kk[2] * rn, kk[3] * rn}, (f32x4){kk[4] * rn, kk[5] * rn, kk[6] * rn, kk[7] * rn});
                if ((lane & 7) == 0) BN[t * 16 + hd] = bs; }
        }
    }
}
namespace att {
constexpr int NW = 8, QBLK = 32, KVBLK = 64;
constexpr float SCALE = 0.125f, THR = 8.f;
constexpr int LDK = PIN, LDO = 2048;
constexpr int SHM_V = KVBLK * 128 * 2, SHM_K = KVBLK * 64 * 2, SHM_ATTN = 2 * SHM_V + 2 * SHM_K + NW * 64 * 4;
#define KSWZ(row, colB) ((row) * 128 + ((colB) ^ (((row) & 7) << 4)))
#define SBAR() __builtin_amdgcn_sched_barrier(0)
__device__ __forceinline__ int crow(int r, int hi) { return (r & 3) + 8 * (r >> 2) + 4 * hi; }
__device__ __forceinline__ void partialSM(f32x16& p0, f32x16& p1, float& m_reg, float& mn, float& alpha) {
  constexpr float C = SCALE * 1.4426950408889634f;
  float pmax = p0[0];
#pragma unroll
  for (int r = 1; r < 16; ++r) pmax = fmaxf(pmax, p0[r]);
#pragma unroll
  for (int r = 0; r < 16; ++r) pmax = fmaxf(pmax, p1[r]);
  { auto rr = __builtin_amdgcn_permlane32_swap(__float_as_uint(pmax), __float_as_uint(pmax), false, false);
    pmax = fmaxf(__uint_as_float(rr[0]), __uint_as_float(rr[1])); }
  if (__builtin_expect(__all(pmax - m_reg <= THR / SCALE), 1)) { mn = m_reg; alpha = 1.f; }
  else { mn = fmaxf(m_reg, pmax); alpha = __builtin_amdgcn_exp2f((m_reg - mn) * C); m_reg = mn; }
  float mnC = -mn * C;
#pragma unroll
  for (int r = 0; r < 16; ++r) p0[r] = fmaf(p0[r], C, mnC);
#pragma unroll
  for (int r = 0; r < 16; ++r) p1[r] = fmaf(p1[r], C, mnC);
#pragma unroll
  for (int r = 0; r < 16; ++r) p0[r] = __builtin_amdgcn_exp2f(p0[r]);
}
__device__ __forceinline__ void finishSM(f32x16& p0, f32x16& p1, float alpha, float& l_reg, bf16x8& pa0, bf16x8& pa1, bf16x8& pa2, bf16x8& pa3) {
#pragma unroll
  for (int r = 0; r < 16; ++r) p1[r] = __builtin_amdgcn_exp2f(p1[r]);
  float ps = 0;
#pragma unroll
  for (int r = 0; r < 16; ++r) ps += p0[r];
#pragma unroll
  for (int r = 0; r < 16; ++r) ps += p1[r];
  { auto rr = __builtin_amdgcn_permlane32_swap(__float_as_uint(ps), __float_as_uint(ps), false, false);
    ps = __uint_as_float(rr[0]) + __uint_as_float(rr[1]); }
  l_reg = l_reg * alpha + ps;
#define PK4(P, BASE, OUT) do { unsigned a0 = cvt_pk_bf16(P[BASE + 0], P[BASE + 1]), a1 = cvt_pk_bf16(P[BASE + 2], P[BASE + 3]);   \
    unsigned b0 = cvt_pk_bf16(P[BASE + 4], P[BASE + 5]), b1 = cvt_pk_bf16(P[BASE + 6], P[BASE + 7]);                              \
    auto r0 = __builtin_amdgcn_permlane32_swap(a0, b0, false, false); auto r1 = __builtin_amdgcn_permlane32_swap(a1, b1, false, false); \
    u32x4 w = {r0[0], r1[0], r0[1], r1[1]}; OUT = *reinterpret_cast<bf16x8*>(&w); } while (0)
  PK4(p0, 0, pa0); PK4(p0, 8, pa1); PK4(p1, 0, pa2); PK4(p1, 8, pa3);
#undef PK4
}
__device__ __forceinline__ void qkt(f32x16& p0, f32x16& p1, const char* Ks, const bf16x8* qr, int r32, int hi) {
  p0 = f32x16{}; p1 = f32x16{};
#pragma unroll
  for (int d0 = 0; d0 < 4; ++d0) { int cb = (d0 * 16 + hi * 8) * 2;
    bf16x8 b0 = *reinterpret_cast<const bf16x8*>(Ks + KSWZ(r32, cb));
    bf16x8 b1 = *reinterpret_cast<const bf16x8*>(Ks + KSWZ(32 + r32, cb));
    p0 = __builtin_amdgcn_mfma_f32_32x32x16_bf16(b0, qr[d0], p0, 0, 0, 0);
    p1 = __builtin_amdgcn_mfma_f32_32x32x16_bf16(b1, qr[d0], p1, 0, 0, 0); }
}
__device__ __forceinline__ int v_st(int k, int c) { const int kk = (k & ~0xC) | ((k & 4) << 1) | ((k & 8) >> 1); return ((kk >> 3) * 4 + (c >> 5)) * 512 + ((kk & 7) * 32 + (c & 31)) * 2; }
__device__ __forceinline__ int v_rd_base(int lane) { return ((lane & 3) << 3) | (((lane >> 2) & 3) << 6) | (((lane >> 4) & 1) << 5) | (((lane >> 5) & 1) << 8); }
constexpr int v_rd_off(int d0, int ks, int half) { return d0 * 512 + ks * 4096 + half * 2048; }
template <int OFF> __device__ __forceinline__ s16x4 tr_read(int vb) {
  s16x4 r; asm volatile("ds_read_b64_tr_b16 %0, %1 offset:%2" : "=&v"(r) : "v"(vb), "i"(OFF) : "memory"); return r;
}
template <int D0> __device__ __forceinline__ void pv_one(f32x16& od, int vb, bf16x8 pa0, bf16x8 pa1, bf16x8 pa2, bf16x8 pa3) {
  const s16x4 l0 = tr_read<v_rd_off(D0, 0, 0)>(vb), h0 = tr_read<v_rd_off(D0, 0, 1)>(vb), l1 = tr_read<v_rd_off(D0, 1, 0)>(vb), h1 = tr_read<v_rd_off(D0, 1, 1)>(vb);
  const s16x4 l2 = tr_read<v_rd_off(D0, 2, 0)>(vb), h2 = tr_read<v_rd_off(D0, 2, 1)>(vb), l3 = tr_read<v_rd_off(D0, 3, 0)>(vb), h3 = tr_read<v_rd_off(D0, 3, 1)>(vb);
  asm volatile("s_waitcnt lgkmcnt(0)" ::: "memory"); SBAR();
#define PK(L, H) (bf16x8){L[0], L[1], L[2], L[3], H[0], H[1], H[2], H[3]}
  od = __builtin_amdgcn_mfma_f32_32x32x16_bf16(pa0, PK(l0, h0), od, 0, 0, 0);
  od = __builtin_amdgcn_mfma_f32_32x32x16_bf16(pa1, PK(l1, h1), od, 0, 0, 0);
  od = __builtin_amdgcn_mfma_f32_32x32x16_bf16(pa2, PK(l2, h2), od, 0, 0, 0);
  od = __builtin_amdgcn_mfma_f32_32x32x16_bf16(pa3, PK(l3, h3), od, 0, 0, 0);
#undef PK
}
__device__ __forceinline__ void pv_d0(f32x16* o, int vb, bf16x8 pa0, bf16x8 pa1, bf16x8 pa2, bf16x8 pa3) {
  pv_one<0>(o[0], vb, pa0, pa1, pa2, pa3); pv_one<1>(o[1], vb, pa0, pa1, pa2, pa3); pv_one<2>(o[2], vb, pa0, pa1, pa2, pa3); pv_one<3>(o[3], vb, pa0, pa1, pa2, pa3);
}
__device__ __forceinline__ void attn_body(const bf16_t* __restrict__ Qb, const bf16_t* __restrict__ Kh, const bf16_t* __restrict__ Vh,
                                          bf16_t* __restrict__ Ob, int seq, char* lds, const int tid) {
  const int wid = tid >> 6, lane = tid & 63, r32 = lane & 31, hi = lane >> 5;
  char* V_lds = lds; char* K_lds = lds + 2 * SHM_V;
  float* ws = (float*)(lds + 2 * SHM_V + 2 * SHM_K) + wid * 64; float* li_l = ws; float* al_l = ws + 32;
  float m_reg = -1e30f, l_reg = 0; f32x16 o[4] = {}; bf16x8 qr[4];
  const bf16_t* Qw = Qb + (long)(wid * QBLK + r32) * LDK + hi * 8;
#pragma unroll
  for (int d0 = 0; d0 < 4; ++d0) qr[d0] = *reinterpret_cast<const bf16x8*>(Qw + d0 * 16);
  const int sr = tid >> 4, sc = (tid & 15) * 8, vst0 = v_st(sr, sc), vst1 = v_st(32 + sr, sc);
  const int kr = tid >> 3, kc = (tid & 7) * 8, kst = KSWZ(kr, kc * 2);
  const int vb0 = (int)(uintptr_t)V_lds + v_rd_base(lane);
  struct { bf16x8 vs0, vs1, ks0; } sr_[2];
  const unsigned vo0 = (unsigned)(sr * LDK + sc), vo1 = (unsigned)((32 + sr) * LDK + sc), ko0 = (unsigned)(kr * LDK + kc);
#define SLOAD(i, k0) do { const bf16_t* Vt_ = Vh + (size_t)(k0) * LDK; const bf16_t* Kt_ = Kh + (size_t)(k0) * LDK; \
    sr_[i].vs0 = *reinterpret_cast<const bf16x8*>(Vt_ + vo0); sr_[i].vs1 = *reinterpret_cast<const bf16x8*>(Vt_ + vo1); \
    sr_[i].ks0 = *reinterpret_cast<const bf16x8*>(Kt_ + ko0); } while (0)
#define SWRITE(b, i) do { *(bf16x8*)(V_lds + (b) * SHM_V + vst0) = sr_[i].vs0; *(bf16x8*)(V_lds + (b) * SHM_V + vst1) = sr_[i].vs1; \
    *(bf16x8*)(K_lds + (b) * SHM_K + kst) = sr_[i].ks0; } while (0)
#define SWAIT() asm volatile("s_waitcnt vmcnt(3)" ::: "memory")
#define RESC(a) do { if (__any((a) < 1.f)) { if (hi == 0) al_l[r32] = (a); asm volatile("s_waitcnt lgkmcnt(0)" ::: "memory"); \
    _Pragma("unroll") for (int d = 0; d < 4; ++d) _Pragma("unroll") for (int r = 0; r < 16; ++r) o[d][r] *= al_l[crow(r, hi)]; } } while (0)
  f32x16 pA0, pA1, pB0, pB1; float mnA, mnB, alA, alB; bf16x8 pa0, pa1, pa2, pa3; const int NT = seq / KVBLK;
  constexpr int SE = 0, SO = 1;
  SLOAD(SE, 0); asm volatile("s_waitcnt vmcnt(0)" ::: "memory"); SWRITE(0, SE); __syncthreads();
  qkt(pA0, pA1, K_lds, qr, r32, hi); partialSM(pA0, pA1, m_reg, mnA, alA);
  SLOAD(SO, KVBLK); if (2 < NT) SLOAD(SE, 2 * KVBLK);
  SWAIT(); SWRITE(1, SO); __syncthreads();
  for (int j = 1; j + 1 < NT; j += 2) {
    SBAR(); qkt(pB0, pB1, K_lds + SHM_K, qr, r32, hi);
    finishSM(pA0, pA1, alA, l_reg, pa0, pa1, pa2, pa3); SBAR();
    SLOAD(SO, (j + 2) * KVBLK); SBAR();
    pv_d0(o, vb0, pa0, pa1, pa2, pa3); partialSM(pB0, pB1, m_reg, mnB, alB);
    __syncthreads(); SWAIT(); SWRITE(0, SE);
    RESC(alB); __syncthreads();
    SBAR(); qkt(pA0, pA1, K_lds, qr, r32, hi);
    finishSM(pB0, pB1, alB, l_reg, pa0, pa1, pa2, pa3); SBAR();
    if (j + 3 < NT) SLOAD(SE, (j + 3) * KVBLK); SBAR();
    pv_d0(o, vb0 + (int)SHM_V, pa0, pa1, pa2, pa3); partialSM(pA0, pA1, m_reg, mnA, alA);
    __syncthreads(); SWAIT(); SWRITE(1, SO);
    RESC(alA); __syncthreads();
  }
  SBAR(); qkt(pB0, pB1, K_lds + SHM_K, qr, r32, hi);
  finishSM(pA0, pA1, alA, l_reg, pa0, pa1, pa2, pa3); SBAR();
  pv_d0(o, vb0, pa0, pa1, pa2, pa3); partialSM(pB0, pB1, m_reg, mnB, alB);
  __syncthreads(); RESC(alB);
  finishSM(pB0, pB1, alB, l_reg, pa0, pa1, pa2, pa3); SBAR();
  pv_d0(o, vb0 + (int)SHM_V, pa0, pa1, pa2, pa3);
  if (hi == 0) li_l[r32] = l_reg; asm volatile("s_waitcnt lgkmcnt(0)" ::: "memory");
  float rli[16];
#pragma unroll
  for (int r = 0; r < 16; ++r) rli[r] = __builtin_amdgcn_rcpf(li_l[crow(r, hi)]);
  bf16_t* Ow = Ob + (long)(wid * QBLK) * LDO;
  { bf16_t* stg = (bf16_t*)(lds + 53248) + wid * 4096;
#pragma unroll
    for (int r = 0; r < 16; ++r) { const int orow = crow(r, hi);
#pragma unroll
      for (int d0 = 0; d0 < 4; ++d0) stg[orow * 128 + d0 * 32 + r32] = (bf16_t)(cvt_pk_bf16(o[d0][r] * rli[r], 0.f) & 0xffffu); }
    asm volatile("s_waitcnt lgkmcnt(0)" ::: "memory");
#pragma unroll
    for (int j = 0; j < 8; ++j) { const int idx = j * 64 + lane, row = idx >> 4, ch = idx & 15;
      *(u32x4*)(Ow + (long)row * LDO + ch * 8) = *(const u32x4*)(stg + row * 128 + ch * 8); } }
  __syncthreads();
#undef SLOAD
#undef SWRITE
#undef SWAIT
#undef RESC
}
#undef SBAR
}

constexpr int SCAN_TB = 32, SCAN_STEP_B = 6 * 64 * 4, SCAN_BUF_B = SCAN_TB * SCAN_STEP_B;
#define DPP_Q1 "quad_perm:[1,0,3,2] row_mask:0xf bank_mask:0xf"
#define DPP_Q2 "quad_perm:[2,3,0,1] row_mask:0xf bank_mask:0xf"
#define DPP_HM "row_half_mirror row_mask:0xf bank_mask:0xf"
#define DPP_RM "row_mirror row_mask:0xf bank_mask:0xf"
__device__ __forceinline__ void allreduce16x4(float& a, float& b, float& c, float& d) {
    asm volatile("s_nop 1\n\t"
        "v_add_f32_dpp %0, %0, %0 " DPP_Q1 "\n\tv_add_f32_dpp %1, %1, %1 " DPP_Q1 "\n\tv_add_f32_dpp %2, %2, %2 " DPP_Q1 "\n\tv_add_f32_dpp %3, %3, %3 " DPP_Q1 "\n\t"
        "v_add_f32_dpp %0, %0, %0 " DPP_Q2 "\n\tv_add_f32_dpp %1, %1, %1 " DPP_Q2 "\n\tv_add_f32_dpp %2, %2, %2 " DPP_Q2 "\n\tv_add_f32_dpp %3, %3, %3 " DPP_Q2 "\n\t"
        "v_add_f32_dpp %0, %0, %0 " DPP_HM "\n\tv_add_f32_dpp %1, %1, %1 " DPP_HM "\n\tv_add_f32_dpp %2, %2, %2 " DPP_HM "\n\tv_add_f32_dpp %3, %3, %3 " DPP_HM "\n\t"
        "v_add_f32_dpp %0, %0, %0 " DPP_RM "\n\tv_add_f32_dpp %1, %1, %1 " DPP_RM "\n\tv_add_f32_dpp %2, %2, %2 " DPP_RM "\n\tv_add_f32_dpp %3, %3, %3 " DPP_RM "\n\t"
        : "+v"(a), "+v"(b), "+v"(c), "+v"(d));
}
__device__ __forceinline__ void allreduce16x2(float& a, float& b) {
    asm volatile("s_nop 1\n\t"
        "v_add_f32_dpp %0, %0, %0 " DPP_Q1 "\n\tv_add_f32_dpp %1, %1, %1 " DPP_Q1 "\n\ts_nop 0\n\t"
        "v_add_f32_dpp %0, %0, %0 " DPP_Q2 "\n\tv_add_f32_dpp %1, %1, %1 " DPP_Q2 "\n\ts_nop 0\n\t"
        "v_add_f32_dpp %0, %0, %0 " DPP_HM "\n\tv_add_f32_dpp %1, %1, %1 " DPP_HM "\n\ts_nop 0\n\t"
        "v_add_f32_dpp %0, %0, %0 " DPP_RM "\n\tv_add_f32_dpp %1, %1, %1 " DPP_RM "\n\t"
        : "+v"(a), "+v"(b));
}
__device__ __forceinline__ void allreduce8x4(float& a, float& b, float& c, float& d) {
    asm volatile("s_nop 1\n\t"
        "v_add_f32_dpp %0, %0, %0 " DPP_Q1 "\n\tv_add_f32_dpp %1, %1, %1 " DPP_Q1 "\n\tv_add_f32_dpp %2, %2, %2 " DPP_Q1 "\n\tv_add_f32_dpp %3, %3, %3 " DPP_Q1 "\n\t"
        "v_add_f32_dpp %0, %0, %0 " DPP_Q2 "\n\tv_add_f32_dpp %1, %1, %1 " DPP_Q2 "\n\tv_add_f32_dpp %2, %2, %2 " DPP_Q2 "\n\tv_add_f32_dpp %3, %3, %3 " DPP_Q2 "\n\t"
        "v_add_f32_dpp %0, %0, %0 " DPP_HM "\n\tv_add_f32_dpp %1, %1, %1 " DPP_HM "\n\tv_add_f32_dpp %2, %2, %2 " DPP_HM "\n\tv_add_f32_dpp %3, %3, %3 " DPP_HM "\n\t"
        : "+v"(a), "+v"(b), "+v"(c), "+v"(d));
}
__device__ __forceinline__ void allreduce8x2(float& a, float& b) {
    asm volatile("s_nop 1\n\t"
        "v_add_f32_dpp %0, %0, %0 " DPP_Q1 "\n\tv_add_f32_dpp %1, %1, %1 " DPP_Q1 "\n\ts_nop 0\n\t"
        "v_add_f32_dpp %0, %0, %0 " DPP_Q2 "\n\tv_add_f32_dpp %1, %1, %1 " DPP_Q2 "\n\ts_nop 0\n\t"
        "v_add_f32_dpp %0, %0, %0 " DPP_HM "\n\tv_add_f32_dpp %1, %1, %1 " DPP_HM "\n\t"
        : "+v"(a), "+v"(b));
}
template <int R>
__device__ __forceinline__ void scan_unit(const Args& a, int b_loc, int head, int dir, int rbase, int S, LAS unsigned char* lds, const int tid) {
    const int ls = tid >> 4, lc = tid & 15;
    unsigned char* ws = a.ws;
    const bf16_t* CV = (const bf16_t*)(ws + WS_CONV); const bf16_t* LO = (const bf16_t*)(ws + WS_LORA);
    float* O = (float*)(ws + (dir ? WS_OB : WS_OF));
    const long rowbase = (long)b_loc * S;
    const f32x4 ka = *(const f32x4*)(a.k_a + head * 64 + 4 * lc);
    const int NB = S / SCAN_TB;
    u32x2 lr, lk, lv, lkk, lu, la, lkn;
#define SC_TOKI(i) (rowbase + (dir ? (S - 1 - (i)) : (i)))
#define SC_LOAD(blk) do { const int i_ = (blk) * SCAN_TB + ls; const long tk_ = SC_TOKI(i_), tn_ = SC_TOKI(i_ + 1 < S ? i_ + 1 : i_); \
        const bf16_t* cv_ = CV + (tk_ * 16 + head) * 256 + 4 * lc; const bf16_t* lo_ = LO + tk_ * 4096 + dir * 1024 + head * 64 + 4 * lc; \
        lr = *(const u32x2*)(cv_); lk = *(const u32x2*)(cv_ + 64); lv = *(const u32x2*)(cv_ + 128); lkk = *(const u32x2*)(cv_ + 192); lu = *(const u32x2*)(lo_); la = *(const u32x2*)(lo_ + 2048); \
        lkn = *(const u32x2*)(CV + (tn_ * 16 + head) * 256 + 192 + 4 * lc); } while (0)
#define SC_WRITE(buf) do { const f32x4 r_ = unp4(lr), k_ = unp4(lk), v_ = unp4(lv), kk_ = unp4(lkk), u_ = unp4(lu), a_ = unp4(la), kn_ = unp4(lkn); \
        LAS f32x4* p_ = (LAS f32x4*)(lds + (buf) * SCAN_BUF_B + ls * SCAN_STEP_B); \
        p_[lc] = u_; p_[16 + lc] = kk_ * a_; p_[32 + lc] = k_ * (1.0f + (a_ - 1.0f) * ka); \
        p_[48 + 2 * lc] = (f32x4){r_[0], -kn_[0], r_[1], -kn_[1]}; p_[48 + 2 * lc + 1] = (f32x4){r_[2], -kn_[2], r_[3], -kn_[3]}; p_[80 + lc] = v_; } while (0)
    const int g = tid >> 3, c = tid & 7;
    const bool worker = tid < 256;
    f32x2 s2[R][4];
    float sa[2] = {0.f, 0.f}, ok[2] = {0.f, 0.f};
#pragma unroll
    for (int j = 0; j < R; ++j)
#pragma unroll
        for (int i = 0; i < 4; ++i) s2[j][i] = (f32x2){0.f, 0.f};
    SC_LOAD(0); SC_WRITE(0); __syncthreads();
    float* Ocol = O + head * 64 + rbase + R * g;
    for (int blk = 0; blk < NB; ++blk) {
        if (blk + 1 < NB) SC_LOAD(blk + 1);
        if (worker) {
            const LAS unsigned char* bp = lds + (blk & 1) * SCAN_BUF_B;
#pragma unroll 2
            for (int st = 0; st < SCAN_TB; ++st) {
                const LAS f32x4* p = (const LAS f32x4*)(bp + st * SCAN_STEP_B);
                const f32x4 u0 = p[2 * c], u1 = p[2 * c + 1], b0 = p[16 + 2 * c], b1 = p[16 + 2 * c + 1], k0 = p[32 + 2 * c], k1 = p[32 + 2 * c + 1];
                const f32x4 rn0 = p[48 + 4 * c], rn1 = p[48 + 4 * c + 1], rn2 = p[48 + 4 * c + 2], rn3 = p[48 + 4 * c + 3];
                float vv[2];
                if (R == 2) { const f32x2 v2 = *(const LAS f32x2*)(bp + st * SCAN_STEP_B + 1280 + (rbase + 2 * g) * 4); vv[0] = v2[0]; vv[1] = v2[1]; }
                else { vv[0] = *(const LAS float*)(bp + st * SCAN_STEP_B + 1280 + (rbase + g) * 4); vv[1] = 0.f; }
                const f32x2 uu[4] = {(f32x2){u0[0], u0[1]}, (f32x2){u0[2], u0[3]}, (f32x2){u1[0], u1[1]}, (f32x2){u1[2], u1[3]}};
                const f32x2 bb[4] = {(f32x2){b0[0], b0[1]}, (f32x2){b0[2], b0[3]}, (f32x2){b1[0], b1[1]}, (f32x2){b1[2], b1[3]}};
                const f32x2 kd[4] = {(f32x2){k0[0], k0[1]}, (f32x2){k0[2], k0[3]}, (f32x2){k1[0], k1[1]}, (f32x2){k1[2], k1[3]}};
                const f32x4 rn[4] = {rn0, rn1, rn2, rn3};
                float o[2] = {0.f, 0.f}, sn[2] = {0.f, 0.f};
#pragma unroll
                for (int j = 0; j < R; ++j) {
                    f32x2 acc = (f32x2){0.f, 0.f};
#pragma unroll
                    for (int i = 0; i < 4; ++i) {
                        f32x2 t = s2[j][i] - s2[j][i] * uu[i]; t = t + sa[j] * bb[i]; t = t + vv[j] * kd[i]; s2[j][i] = t;
                        acc = acc + t[0] * (f32x2){rn[i][0], rn[i][1]}; acc = acc + t[1] * (f32x2){rn[i][2], rn[i][3]};
                    }
                    o[j] = acc[0]; sn[j] = acc[1];
                }
                if (R == 2) allreduce8x4(o[0], o[1], sn[0], sn[1]); else allreduce8x2(o[0], sn[0]);
                sa[0] = sn[0]; sa[1] = sn[1];
                const bool mine = ((st & 7) == c);
                ok[0] = mine ? o[0] : ok[0]; if (R == 2) ok[1] = mine ? o[1] : ok[1];
                if ((st & 7) == 7) {
                    float* op = Ocol + SC_TOKI(blk * SCAN_TB + (st & 24) + c) * 1024;
                    if (R == 2) *(f32x2*)op = (f32x2){ok[0], ok[1]}; else *op = ok[0];
                }
            }
        }
        if (blk + 1 < NB) SC_WRITE((blk + 1) & 1);
        __syncthreads();
    }
#undef SC_TOKI
#undef SC_LOAD
#undef SC_WRITE
}

namespace cs {
constexpr int SA = 64, SB = 32, SV = 16;
constexpr int SAR = 72;
constexpr int O_AR = 0, O_BKT = 4608, O_VT = 8704, O_GM = 10752, O_XT = 12800, O_GC = 13824, SLOT_B = 14080;
constexpr int NPROD = 5;
constexpr int O_PSCR = 2 * NPROD * SLOT_B, PSCR_B = 1024, O_CSCR = O_PSCR + NPROD * PSCR_B, CSCR_B = 0;
static_assert(O_CSCR + 2 * CSCR_B <= LDS_BYTES - 64, "scan LDS map");
__device__ __forceinline__ int crow(int r, int hi) { return (r & 3) + 8 * (r >> 2) + 4 * hi; }
__device__ __forceinline__ bf16_t tobf(float x) { return (bf16_t)(cvt_pk_bf16(x, 0.f) & 0xffffu); }
#define CS_LWAIT() asm volatile("s_waitcnt lgkmcnt(0)" ::: "memory")

struct PRaw { u32x4 c[8]; u32x4 o[4]; };
__device__ __forceinline__ void produce_load(PRaw& R, const Args& a, long rowbase, int head, int dir, int S, int q, int l) {
    const bf16_t* CV = (const bf16_t*)(a.ws + WS_CONV); const bf16_t* LO = (const bf16_t*)(a.ws + WS_LORA);
#pragma unroll
    for (int j = 0; j < 8; ++j) { const int t = 2 * j + (l >> 5), i = 16 * q + t; const long tok = rowbase + (dir ? (S - 1 - i) : i);
        R.c[j] = *(const u32x4*)(CV + (tok * 16 + head) * 256 + (l & 31) * 8); }
#pragma unroll
    for (int j = 0; j < 4; ++j) { const int t = 4 * j + (l >> 4), i = 16 * q + t; const long tok = rowbase + (dir ? (S - 1 - i) : i);
        R.o[j] = *(const u32x4*)(LO + tok * 4096 + dir * 1024 + head * 64 + ((l >> 3) & 1) * 2048 + (l & 7) * 8); }
}
__device__ __forceinline__ void produce_build(const PRaw& R, const Args& a, LAS unsigned char* slot, LAS unsigned char* scr, int head, int l) {
    LAS bf16_t* AR = (LAS bf16_t*)(slot + O_AR); LAS bf16_t* BKt = (LAS bf16_t*)(slot + O_BKT); LAS bf16_t* Vt = (LAS bf16_t*)(slot + O_VT);
    LAS bf16_t* GM = (LAS bf16_t*)(slot + O_GM); LAS bf16_t* XT = (LAS bf16_t*)(slot + O_XT);
    LAS float* GC = (LAS float*)(slot + O_GC); LAS bf16_t* BK = (LAS bf16_t*)(slot + O_VT); LAS float* NM = (LAS float*)scr;
    const float ka = a.k_a[head * 64 + l];
    const int pl = (l & 32) | (((l >> 4) & 1) << 4) | (((l >> 2) & 1) << 3) | (((l >> 3) & 1) << 2) | (l & 3);
    { LAS unsigned char* raw = (LAS unsigned char*)slot;
#pragma unroll
      for (int j = 0; j < 8; ++j) *(LAS u32x4*)(raw + (2 * j + (l >> 5)) * 512 + (l & 31) * 16) = R.c[j];
#pragma unroll
      for (int j = 0; j < 4; ++j) *(LAS u32x4*)(raw + 8192 + (4 * j + (l >> 4)) * 256 + ((l >> 3) & 1) * 128 + (l & 7) * 16) = R.o[j]; }
    CS_LWAIT();
    bf16_t Lr[16], Lk[16], Lv[16], Lkk[16], Lu[16], La[16];
    { const LAS bf16_t* raw = (const LAS bf16_t*)slot;
#pragma unroll
      for (int t = 0; t < 16; ++t) { Lr[t] = raw[t * 256 + l]; Lk[t] = raw[t * 256 + 64 + l]; Lv[t] = raw[t * 256 + 128 + l]; Lkk[t] = raw[t * 256 + 192 + l];
          Lu[t] = raw[4096 + t * 128 + l]; La[t] = raw[4096 + t * 128 + 64 + l]; } }
    CS_LWAIT();
    float g = 1.0f, ig = 1.0f;
    u32x4 pb[2], pk[2], pv[2];
#pragma unroll
    for (int t2 = 0; t2 < 8; ++t2) {
        float ah[2], rh[2], bh[2], kh[2];
#pragma unroll
        for (int e = 0; e < 2; ++e) { const int t = 2 * t2 + e;
            const float r = bf1(Lr[t]), k = bf1(Lk[t]), kk = bf1(Lkk[t]), u = bf1(Lu[t]), aa = bf1(La[t]);
            const float gp = g, w_ = 1.0f - u; g = g * w_; ig = ig * __builtin_amdgcn_rcpf(w_);
            ah[e] = -kk * gp; rh[e] = r * g; bh[e] = kk * aa * ig; kh[e] = k * (1.0f + (aa - 1.0f) * ka) * ig; }
        const unsigned wa = cvt_pk_bf16(ah[0], ah[1]), wr = cvt_pk_bf16(rh[0], rh[1]), wb = cvt_pk_bf16(bh[0], bh[1]), wk = cvt_pk_bf16(kh[0], kh[1]);
        const int t = 2 * t2;
        AR[t * SAR + pl] = (bf16_t)(wa & 0xffffu); AR[(t + 1) * SAR + pl] = (bf16_t)(wa >> 16);
        AR[(16 + t) * SAR + pl] = (bf16_t)(wr & 0xffffu); AR[(17 + t) * SAR + pl] = (bf16_t)(wr >> 16);
        BK[t * SA + pl] = (bf16_t)(wb & 0xffffu); BK[(t + 1) * SA + pl] = (bf16_t)(wb >> 16);
        BK[(16 + t) * SA + pl] = (bf16_t)(wk & 0xffffu); BK[(17 + t) * SA + pl] = (bf16_t)(wk >> 16);
        { constexpr int pp[8] = {0, 1, 4, 5, 2, 3, 6, 7}; pb[pp[t2] >> 2][pp[t2] & 3] = wb; }
        pk[t2 >> 2][t2 & 3] = wk;
        pv[t2 >> 2][t2 & 3] = ((unsigned)Lv[t]) | (((unsigned)Lv[t + 1]) << 16);
    }
    { LAS u32x4* bt = (LAS u32x4*)(BKt + l * SB); bt[0] = pb[0]; bt[1] = pb[1]; bt[2] = pk[0]; bt[3] = pk[1]; }
    GC[l] = g;
    CS_LWAIT();
    const int n = l & 31, hi = l >> 5;
    f32x16 G = {};
#pragma unroll
    for (int ks = 0; ks < 4; ++ks) {
        const bf16x8 fa = *(const LAS bf16x8*)(AR + n * SAR + 16 * ks + 8 * hi), fb = *(const LAS bf16x8*)(BK + n * SA + 16 * ks + 8 * hi);
        G = __builtin_amdgcn_mfma_f32_32x32x16_bf16(fa, fb, G, 0, 0, 0);
    }
    CS_LWAIT();
    { LAS u32x4* vt = (LAS u32x4*)(Vt + l * SV); vt[0] = pv[0]; vt[1] = pv[1]; }
#pragma unroll
    for (int r = 0; r < 16; ++r) {
        const int tp = crow(r, hi); const float val = G[r];
        const int j = n & 15;
        const bool keep = (r < 8) ? ((n >= 16) && (j < tp)) : (j <= tp - 16);
        const int gcol = (n < 16) ? ((((n >> 2) & 1) << 3) | ((n >> 3) << 2) | (n & 3)) : n;
        GM[tp * SB + gcol] = keep ? tobf(val) : (bf16_t)0;
    }
    if (n < 16) {
#pragma unroll
        for (int r = 0; r < 8; ++r) { const int tp = crow(r, hi); NM[tp * 16 + n] = (n < tp) ? G[r] : 0.f; }
    }
    { const int rr = 16 + (l >> 2), cc = (l & 3) * 4; LAS u32x2* z = (LAS u32x2*)(XT + rr * SV + cc); *z = (u32x2){0u, 0u}; }
    CS_LWAIT();
    { const int c = l & 15; float x[16];
#pragma unroll
      for (int t = 0; t < 16; ++t) {
          const f32x4 n0 = *(const LAS f32x4*)(NM + t * 16), n1 = *(const LAS f32x4*)(NM + t * 16 + 4), n2 = *(const LAS f32x4*)(NM + t * 16 + 8), n3 = *(const LAS f32x4*)(NM + t * 16 + 12);
          const float nr[16] = {n0[0], n0[1], n0[2], n0[3], n1[0], n1[1], n1[2], n1[3], n2[0], n2[1], n2[2], n2[3], n3[0], n3[1], n3[2], n3[3]};
          float ac[4] = {(t == c) ? 1.0f : 0.0f, 0.f, 0.f, 0.f};
#pragma unroll
          for (int j = 0; j < t; ++j) ac[j & 3] = fmaf(nr[j], x[j], ac[j & 3]);
          x[t] = (ac[0] + ac[1]) + (ac[2] + ac[3]);
      }
      if (l < 16) {
#pragma unroll
          for (int t = 0; t < 16; ++t) XT[t * SV + ((((c >> 2) & 1) << 3) | ((c >> 3) << 2) | (c & 3))] = tobf(x[t]);
      } }
    CS_LWAIT();
}

__device__ __forceinline__ bf16x8 pack_acc8(const f32x16& d, int base) {
    u32x4 w; w.x = cvt_pk_bf16(d[base + 0], d[base + 1]); w.y = cvt_pk_bf16(d[base + 2], d[base + 3]); w.z = cvt_pk_bf16(d[base + 4], d[base + 5]); w.w = cvt_pk_bf16(d[base + 6], d[base + 7]);
    return __builtin_bit_cast(bf16x8, w);
}
__device__ __forceinline__ void consume(const LAS unsigned char* slot, f32x16 (&DS)[2], bf16_t* Obase, long rowoff, int dir, int S, int q, int cw, int l) {
    const LAS bf16_t* AR = (const LAS bf16_t*)(slot + O_AR); const LAS bf16_t* BKt = (const LAS bf16_t*)(slot + O_BKT); const LAS bf16_t* Vt = (const LAS bf16_t*)(slot + O_VT);
    const LAS bf16_t* GM = (const LAS bf16_t*)(slot + O_GM); const LAS bf16_t* XT = (const LAS bf16_t*)(slot + O_XT);
    const LAS float* GC = (const LAS float*)(slot + O_GC);
    const int n = l & 31, hi = l >> 5;
    bf16x8 aA[4], aK0[2], aK1[2]; f32x4 gc[2][4];
#pragma unroll
    for (int i = 0; i < 4; ++i) aA[i] = *(const LAS bf16x8*)(AR + n * SAR + 16 * i + 8 * hi);
    const bf16x8 bV = *(const LAS bf16x8*)(Vt + (32 * cw + n) * SV + 8 * hi);
    const bf16x8 aAK = *(const LAS bf16x8*)(GM + n * SB + 16 + 8 * hi), aARB = *(const LAS bf16x8*)(GM + n * SB + 8 * hi), aX = *(const LAS bf16x8*)(XT + n * SV + 8 * hi);
#pragma unroll
    for (int bm = 0; bm < 2; ++bm) { aK0[bm] = *(const LAS bf16x8*)(BKt + (32 * bm + n) * SB + 8 * hi); aK1[bm] = *(const LAS bf16x8*)(BKt + (32 * bm + n) * SB + 16 + 8 * hi);
#pragma unroll
        for (int g4 = 0; g4 < 4; ++g4) gc[bm][g4] = *(const LAS f32x4*)(GC + 32 * bm + 8 * g4 + 4 * hi); }
    f32x16 D1 = {};
#pragma unroll
    for (int bm = 0; bm < 2; ++bm)
#pragma unroll
        for (int sp = 0; sp < 2; ++sp) D1 = __builtin_amdgcn_mfma_f32_32x32x16_bf16(aA[2 * bm + sp], pack_acc8(DS[bm], 8 * sp), D1, 0, 0, 0);
    D1 = __builtin_amdgcn_mfma_f32_32x32x16_bf16(aAK, bV, D1, 0, 0, 0);
    f32x16 UA = {};
    UA = __builtin_amdgcn_mfma_f32_32x32x16_bf16(aX, pack_acc8(D1, 0), UA, 0, 0, 0);
    const bf16x8 bU = pack_acc8(UA, 0);
    D1 = __builtin_amdgcn_mfma_f32_32x32x16_bf16(aARB, bU, D1, 0, 0, 0);
#pragma unroll
    for (int bm = 0; bm < 2; ++bm) {
        DS[bm] = __builtin_amdgcn_mfma_f32_32x32x16_bf16(aK0[bm], bU, DS[bm], 0, 0, 0);
        DS[bm] = __builtin_amdgcn_mfma_f32_32x32x16_bf16(aK1[bm], bV, DS[bm], 0, 0, 0);
#pragma unroll
        for (int r = 0; r < 16; ++r) DS[bm][r] *= gc[bm][r >> 2][r & 3];
    }
    if (dir) { bf16_t* p0 = Obase + (rowoff + (S - 1 - 16 * q) - 4 * hi) * 1024 + n;
#pragma unroll
        for (int r = 8; r < 16; ++r) p0[-1024 * ((r & 3) + 8 * ((r >> 2) - 2))] = tobf(D1[r]);
    } else { bf16_t* p0 = Obase + (rowoff + 16 * q + 4 * hi) * 1024 + n;
#pragma unroll
        for (int r = 8; r < 16; ++r) p0[1024 * ((r & 3) + 8 * ((r >> 2) - 2))] = tobf(D1[r]);
    }
}

__device__ __forceinline__ void aux_rows(const float* __restrict__ xnext, bf16_t* __restrict__ xn_out, const f32x4 (&gn)[4], float* __restrict__ oprev, const f32x4 (&gf)[4],
                                         int rb, int re, int l) {
    f32x4 vx[3][4], vo[3][4];
#pragma unroll
    for (int i = 0; i < 3; ++i) { const int row = rb + i;
        if (row < re) {
            if (xnext) {
#pragma unroll
                for (int j = 0; j < 4; ++j) vx[i][j] = __builtin_nontemporal_load((const f32x4*)(xnext + (size_t)row * DM) + l + 64 * j); }
            if (oprev) {
#pragma unroll
                for (int j = 0; j < 4; ++j) vo[i][j] = __builtin_nontemporal_load((const f32x4*)(oprev + (size_t)row * DM) + l + 64 * j); }
        } }
#pragma unroll
    for (int i = 0; i < 3; ++i) { const int row = rb + i;
        if (row < re) {
            if (xnext) { float sx = 0.f;
#pragma unroll
                for (int j = 0; j < 4; ++j) sx += (vx[i][j].x * vx[i][j].x + vx[i][j].y * vx[i][j].y) + (vx[i][j].z * vx[i][j].z + vx[i][j].w * vx[i][j].w);
                const float rstd = 1.0f / sqrtf(wave_sum(sx) * (1.f / DM) + 1e-6f);
                u32x2* o8 = (u32x2*)(xn_out + (size_t)row * DM) + l;
#pragma unroll
                for (int j = 0; j < 4; ++j) { u32x2 w; w.x = cvt_pk_bf16(vx[i][j].x * rstd * gn[j].x, vx[i][j].y * rstd * gn[j].y); w.y = cvt_pk_bf16(vx[i][j].z * rstd * gn[j].z, vx[i][j].w * rstd * gn[j].w); o8[64 * j] = w; } }
            if (oprev) { float so = 0.f;
#pragma unroll
                for (int j = 0; j < 4; ++j) so += (vo[i][j].x * vo[i][j].x + vo[i][j].y * vo[i][j].y) + (vo[i][j].z * vo[i][j].z + vo[i][j].w * vo[i][j].w);
                const float rstd = 1.0f / sqrtf(wave_sum(so) * (1.f / DM) + 1e-6f);
                f32x4* op = (f32x4*)(oprev + (size_t)row * DM) + l;
#pragma unroll
                for (int j = 0; j < 4; ++j) __builtin_nontemporal_store(vo[i][j] * rstd * gf[j], op + 64 * j); }
        } }
}

__device__ __forceinline__ void scan_unit(const Args& a, int b_loc, int head, int dir, int S, LAS unsigned char* lds, const int tid,
                                          const float* xnext, bf16_t* xn_out, float* oprev, const int arow0, const int arows) {
    const int wv = __builtin_amdgcn_readfirstlane(tid >> 6), l = tid & 63;
    const long rowbase = (long)b_loc * S;
    const int NCH = S / 16, NG = (NCH + NPROD - 1) / NPROD;
    bf16_t* O = (bf16_t*)(a.ws + (dir ? WS_OB : WS_OF));
    f32x16 DS[2] = {};
    const bool prod = (wv >= 2 && wv < 2 + NPROD);
    PRaw R;
    if (prod) { produce_load(R, a, rowbase, head, dir, S, wv - 2, l);
                produce_build(R, a, lds + (wv - 2) * SLOT_B, lds + O_PSCR + (wv - 2) * PSCR_B, head, l);
                produce_load(R, a, rowbase, head, dir, S, NPROD + (wv - 2), l); }
    f32x4 gn[4], gf[4];
    if (wv == 7) {
#pragma unroll
        for (int j = 0; j < 4; ++j) { gn[j] = ((const f32x4*)a.norm_g)[l + 64 * j]; gf[j] = ((const f32x4*)a.final_g)[l + 64 * j]; } }
    __syncthreads();
    for (int g = 0; g < NG; ++g) {
        int l2 = l; asm volatile("" : "+v"(l2));
        if (wv == 7) aux_rows(xnext, xn_out, gn, oprev, gf, arow0 + (g * arows) / NG, arow0 + ((g + 1) * arows) / NG, l2);
        else if (prod) { const int q = NPROD * (g + 1) + (wv - 2);
            if (q < NCH) { produce_build(R, a, lds + (((g + 1) & 1) * NPROD + (wv - 2)) * SLOT_B, lds + O_PSCR + (wv - 2) * PSCR_B, head, l2);
                           if (q + NPROD < NCH) produce_load(R, a, rowbase, head, dir, S, q + NPROD, l2); } }
        else if (wv < 2) {
            for (int c = 0; c < NPROD; ++c) { const int q = NPROD * g + c; int l3 = l2; asm volatile("" : "+v"(l3));
                if (q < NCH) consume(lds + ((g & 1) * NPROD + c) * SLOT_B, DS, O + head * 64 + 32 * wv, rowbase, dir, S, q, wv, l3); }
        }
        __syncthreads();
    }
}
}

__device__ __forceinline__ void phase_post(const Args& a, int gw, int NGW, int lane) {
    unsigned char* ws = a.ws;
    const bf16_t* H = (const bf16_t*)(ws + WS_H); const bf16_t* AT = (const bf16_t*)(ws + WS_ATT);
    const bf16_t* OF = (const bf16_t*)(ws + WS_OF); const bf16_t* OB = (const bf16_t*)(ws + WS_OB);
    const bf16_t* CV = (const bf16_t*)(ws + WS_CONV); const float* BN = (const float*)(ws + WS_BONUS);
    bf16_t* OA = (bf16_t*)(ws + WS_OA); bf16_t* ORG = (bf16_t*)(ws + WS_ORG);
    const float d1 = wave_sum(a.lq1[lane] * a.lk1[lane]), d2 = wave_sum(a.lq2[lane] * a.lk2[lane]);
    const float lam = expf(d1) - expf(d2) + 0.2f;
    const int q = lane >> 4, l16 = lane & 15;
    {
        const f32x4 sg0 = *(const f32x4*)(a.subln_g + 8 * l16) * 0.8f, sg1 = *(const f32x4*)(a.subln_g + 8 * l16 + 4) * 0.8f;
        for (int it0 = gw * 4 + q; it0 < TCH * 8; it0 += NGW * 8) {
            u32x4 ra[2], rb[2], rg[2];
#pragma unroll
            for (int e = 0; e < 2; ++e) { const int it = it0 + e * NGW * 4, t = it >> 3, h = it & 7; if (it >= TCH * 8) continue;
                const bf16_t* p1 = AT + (size_t)t * 2048 + (h * 2) * 128 + 8 * l16;
                ra[e] = __builtin_nontemporal_load((const u32x4*)p1); rb[e] = __builtin_nontemporal_load((const u32x4*)(p1 + 128)); rg[e] = __builtin_nontemporal_load((const u32x4*)(H + (size_t)t * PIN + C_GA + h * 128 + 8 * l16)); }
#pragma unroll
            for (int e = 0; e < 2; ++e) { const int it = it0 + e * NGW * 4, t = it >> 3, h = it & 7; if (it >= TCH * 8) continue;
                float fa[8], fb[8], gt[8]; unpack8(ra[e], fa); unpack8(rb[e], fb); unpack8(rg[e], gt);
                float x[8], ss = 0.f;
#pragma unroll
                for (int i = 0; i < 8; ++i) { x[i] = fa[i] - lam * fb[i]; ss = fmaf(x[i], x[i], ss); }
                ss = allreduce16(ss);
                const float rstd = 1.0f / sqrtf(ss * (1.0f / 128.0f) + 1e-5f);
                float y[8];
#pragma unroll
                for (int i = 0; i < 8; ++i) y[i] = x[i] * rstd * (i < 4 ? sg0[i] : sg1[i - 4]) * gt[i] * fsigmoid(gt[i]);
                *(u32x4*)(OA + (size_t)t * 2048 + h * 128 + 8 * l16) = pack8((f32x4){y[0], y[1], y[2], y[3]}, (f32x4){y[4], y[5], y[6], y[7]}); }
        }
    }
    {
        const int hd = 8 * (gw & 1) + (lane >> 3), hc = hd * 64 + 8 * (lane & 7);
        const f32x4 lg0 = *(const f32x4*)(a.lnx_g + hc), lg1 = *(const f32x4*)(a.lnx_g + hc + 4), lb0 = *(const f32x4*)(a.lnx_b + hc), lb1 = *(const f32x4*)(a.lnx_b + hc + 4);
        for (int t0 = gw >> 1; t0 < TCH; t0 += NGW) {
            u32x4 r_of[2], r_ob[2], r_v[2], r_g[2]; float r_bn[2];
#pragma unroll
            for (int e = 0; e < 2; ++e) { const int t = t0 + e * (NGW >> 1); if (t >= TCH) continue;
                r_of[e] = __builtin_nontemporal_load((const u32x4*)(OF + (size_t)t * DM + hc)); r_ob[e] = __builtin_nontemporal_load((const u32x4*)(OB + (size_t)t * DM + hc));
                r_v[e] = __builtin_nontemporal_load((const u32x4*)(CV + ((size_t)t * 16 + hd) * 256 + 128 + 8 * (lane & 7))); r_g[e] = __builtin_nontemporal_load((const u32x4*)(H + (size_t)t * PIN + C_GR + hc)); r_bn[e] = BN[t * 16 + hd]; }
#pragma unroll
            for (int e = 0; e < 2; ++e) { const int t = t0 + e * (NGW >> 1); if (t >= TCH) continue;
                float of[8], ob[8], vv[8], gr[8], o[8];
                unpack8(r_of[e], of); unpack8(r_ob[e], ob); unpack8(r_v[e], vv); unpack8(r_g[e], gr);
                float sm = 0.f;
#pragma unroll
                for (int i = 0; i < 8; ++i) { o[i] = of[i] + ob[i]; sm += o[i]; }
                sm += dpp_mov<0xB1>(sm); sm += dpp_mov<0x4E>(sm); sm += dpp_mov<0x141>(sm);
                const float mu = sm * (1.0f / 64.0f); float vs = 0.f;
#pragma unroll
                for (int i = 0; i < 8; ++i) { o[i] -= mu; vs = fmaf(o[i], o[i], vs); }
                vs += dpp_mov<0xB1>(vs); vs += dpp_mov<0x4E>(vs); vs += dpp_mov<0x141>(vs);
                const float rs = 1.0f / sqrtf(vs * (1.0f / 64.0f) + 64e-5f), bn = r_bn[e];
                float y[8];
#pragma unroll
                for (int i = 0; i < 8; ++i) { const float lg = i < 4 ? lg0[i] : lg1[i - 4], lb = i < 4 ? lb0[i] : lb1[i - 4];
                    y[i] = (o[i] * rs * lg + lb + bn * vv[i]) * gr[i] * fsigmoid(gr[i]); }
                *(u32x4*)(OA + (size_t)t * 2048 + 1024 + hc) = pack8((f32x4){y[0], y[1], y[2], y[3]}, (f32x4){y[4], y[5], y[6], y[7]}); }
        }
    }
}

#define XB_TMO      128
#define XB_XCNT(j)  (256  + 64 * (j))
#define XB_XSUB(j)  (1280 + 64 * (j))
#define XB_XGEN(j)  (2304 + 64 * (j))
#define XB_TOP      3328
#define XB_TOPGEN   3392
#define XCD_BAR_WORDS 3456
#define XB_SPIN_CAP (1u << 20)
__device__ __forceinline__ unsigned xb_ld(unsigned* p)              { return __hip_atomic_load(p, __ATOMIC_RELAXED, __HIP_MEMORY_SCOPE_AGENT); }
__device__ __forceinline__ unsigned xb_add(unsigned* p, unsigned v) { return __hip_atomic_fetch_add(p, v, __ATOMIC_RELAXED, __HIP_MEMORY_SCOPE_AGENT); }
__device__ __forceinline__ unsigned xb_xcc_id() { return (unsigned)__builtin_amdgcn_s_getreg((3 << 11) | 20) & 0xFu; }
#define XB_SPIN(cond, bar) do { unsigned _sp = 0; while (cond) { __builtin_amdgcn_s_sleep(1); \
    if ((++_sp & 255u) == 0u) { if (xb_ld(&(bar)[XB_TMO])) break; if (_sp > XB_SPIN_CAP) { atomicAdd(&(bar)[XB_TMO], 1u); break; } } } } while (0)
__device__ __forceinline__ void xcd_barrier_complete(unsigned* bar, unsigned x, unsigned G, unsigned& nloc, unsigned& nx) {
    unsigned sum, cnt, mine, sp = 0u;
    for (;;) {
        sum = 0u; cnt = 0u; mine = 0u;
#pragma unroll
        for (unsigned j = 0; j < 16; ++j) { const unsigned c = xb_ld(&bar[XB_XCNT(j)]); sum += c; cnt += (c > 0u) ? 1u : 0u; mine = (j == x) ? c : mine; }
        if (sum == G) break;
        __builtin_amdgcn_s_sleep(1);
        if ((++sp & 255u) == 0u) { if (xb_ld(&bar[XB_TMO])) break; if (sp > XB_SPIN_CAP) { atomicAdd(&bar[XB_TMO], 1u); break; } }
    }
    nloc = mine > 0u ? mine : 1u; nx = cnt > 0u ? cnt : 1u;
}
__device__ __forceinline__ void xcd_barrier(unsigned* bar, volatile LAS unsigned* st, const bool t0, const unsigned G) {
    asm volatile("s_waitcnt vmcnt(0)" ::: "memory");
    __syncthreads();
    if (t0) {
        __builtin_amdgcn_s_waitcnt(0);
        const unsigned x = xb_xcc_id();
        unsigned nloc = st[0], nx = st[1];
        if (nloc == 0u) { xcd_barrier_complete(bar, x, G, nloc, nx); st[0] = nloc; st[1] = nx; }
        const unsigned old = xb_add(&bar[XB_XSUB(x)], 1u);
        const unsigned gen = old / nloc;
        if (old + 1u == (gen + 1u) * nloc) {
            __builtin_amdgcn_fence(__ATOMIC_RELEASE, "agent");
            asm volatile("s_waitcnt vmcnt(0)" ::: "memory");
            const unsigned og = xb_add(&bar[XB_TOP], 1u);
            const unsigned tg = og / nx;
            if (og + 1u == (tg + 1u) * nx) xb_add(&bar[XB_TOPGEN], 1u);
            else XB_SPIN(xb_ld(&bar[XB_TOPGEN]) == tg, bar);
            __builtin_amdgcn_fence(__ATOMIC_ACQUIRE, "agent");
            xb_add(&bar[XB_XGEN(x)], 1u);
            asm volatile("s_waitcnt vmcnt(0)" ::: "memory");
        } else {
            XB_SPIN(xb_ld(&bar[XB_XGEN(x)]) == gen, bar);
            __builtin_amdgcn_fence(__ATOMIC_ACQUIRE, "agent");
            asm volatile("s_waitcnt vmcnt(0)" ::: "memory");
        }
    }
    __syncthreads();
}

constexpr int N_PHASES = 1 + 6 * NCHUNK + 1;
#define GET_TID() int wave = wave0; asm volatile("" : "+s"(wave)); \
        unsigned zz = 0u; asm volatile("" : "+v"(zz)); \
        int tid = wave * 64 + (int)__builtin_amdgcn_mbcnt_hi(~0u, __builtin_amdgcn_mbcnt_lo(~0u, zz)); asm volatile("" : "+v"(tid)); \
        int bid = blockIdx.x; asm volatile("" : "+s"(bid)); int G = G0; asm volatile("" : "+s"(G)); \
        const int lane = tid & 63; const int gw = bid * NWAVES + wave, NGW = G * NWAVES; (void)lane; (void)gw; (void)NGW;
#if defined(__HIP_DEVICE_COMPILE__)
#define LOAD_ARGS() typedef const __attribute__((address_space(4))) Args* CArgsP; \
        CArgsP ap = (CArgsP)__builtin_amdgcn_kernarg_segment_ptr(); \
        asm volatile("" : "+s"(ap)); \
        Args a; \
        a.x_p = ap->x_p; a.x_s = ap->x_s; a.norm_g = ap->norm_g; a.w_in = ap->w_in; a.conv = ap->conv; a.lq1 = ap->lq1; a.lk1 = ap->lk1; a.lq2 = ap->lq2; a.lk2 = ap->lk2; \
        a.subln_g = ap->subln_g; a.wlu = ap->wlu; a.w0 = ap->w0; a.alu = ap->alu; a.a0 = ap->a0; a.k_k = ap->k_k; a.k_a = ap->k_a; a.r_k = ap->r_k; a.lnx_g = ap->lnx_g; a.lnx_b = ap->lnx_b; \
        a.w_oa = ap->w_oa; a.w_or = ap->w_or; a.w_out = ap->w_out; a.final_g = ap->final_g; a.out = ap->out; a.ws = ap->ws; a.ph_lo = 0; a.ph_hi = 0; \
        unsigned char* ws = a.ws; unsigned* ctl = (unsigned*)(ws + WS_CTL); bf16_t* XN = (bf16_t*)(ws + WS_XN); bf16_t* H = (bf16_t*)(ws + WS_H); (void)ctl; (void)XN; (void)H;
#else
#define LOAD_ARGS() Args a = a_in; unsigned char* ws = a.ws; unsigned* ctl = (unsigned*)(ws + WS_CTL); bf16_t* XN = (bf16_t*)(ws + WS_XN); bf16_t* H = (bf16_t*)(ws + WS_H); (void)ctl; (void)XN; (void)H;
#endif
__global__ void __launch_bounds__(NTHR, 2) mega_fwd(Args a_in) {
    extern __shared__ __attribute__((aligned(16))) unsigned char lds_raw[];
    LAS unsigned char* lds = (LAS unsigned char*)lds_raw;
    cg::grid_group grid = cg::this_grid();
    const int G0 = gridDim.x;
    volatile LAS unsigned* misc = (volatile LAS unsigned*)(lds + LDS_BYTES - 64);
#ifndef PH_MASK
#define PH_MASK 0xff
#endif
#define PROBE_DUP 0
    const int ph_lo = a_in.ph_lo, ph_hi = a_in.ph_hi;
    const int wave0 = __builtin_amdgcn_readfirstlane(threadIdx.x >> 6);
    if (threadIdx.x < 8) misc[threadIdx.x + 8] = 0u;
    __syncthreads();
    if (threadIdx.x == 0) (void)xb_add((unsigned*)(a_in.ws + WS_CTL) + 4096 + XB_XCNT(xb_xcc_id()), 1u);
    for (int p = ph_lo; p < ph_hi; ++p) {
        if (p == 0) { if (!(PH_MASK & 1)) continue; LOAD_ARGS(); GET_TID();
            for (int rep = 0; rep < ((PROBE_DUP & 64) ? 3 : 1); ++rep) {
            phase_weights(a, lds, gw, NGW, lane, wave);
            phase_xn(a.x_p, a.norm_g, XN, TCH, gw, NGW, lane); }
        } else if (p == N_PHASES - 1) { if (!(PH_MASK & 128)) continue; LOAD_ARGS(); GET_TID();
            phase_final(a.out + (size_t)(NCHUNK - 1) * TCH * DM, a.final_g, TCH, gw, NGW, lane);
        } else {
            const int ch = (p - 1) / 6, sub = (p - 1) % 6;
            const int S = ch < 4 ? 2048 : 4096, nb = TCH / S;
            const size_t grow = (size_t)ch * TCH;
            if (sub == 0) { if (!(PH_MASK & 2) || ch >= 1) continue; LOAD_ARGS(); GET_TID();
                {
                pg8::Gemm g{XN, (const bf16_t*)(ws + WS_WIN), TCH, PIN, DM, DM, DM}; pg8::StaticOrder So; So.init(TCH, PIN, G, bid, (PROBE_DUP & 1) ? 2 : 1);
                EpiIn E{H, (bf16_t*)(ws + WS_LW), (const f32x4*)(ws + WS_ROPE), S - 1}; pg8::gemm_phase<DM, DM>(lds, g, So, E, tid); }
            } else if (sub == 1) { if (!(PH_MASK & 4)) continue; LOAD_ARGS(); GET_TID();
#ifndef NO_PREP
                phase_prep(a, S, gw, NGW, lane, false);
#endif
                { if (PROBE_DUP & 2) phase_prep(a, S, gw, NGW, lane, false);
                pg8::Gemm g{(const bf16_t*)(ws + WS_LW), (const bf16_t*)(ws + WS_WLORA), TCH, 4096, 256, 256, 256}; pg8::StaticOrder So; So.init(TCH, 4096, G, bid, (PROBE_DUP & 4) ? 2 : 1);
                EpiLora E{(bf16_t*)(ws + WS_LORA), a.w0, a.a0}; pg8::gemm_phase<256, 256>(lds, g, So, E, tid); }
            } else if (sub == 2) { if (!(PH_MASK & 8)) continue; LOAD_ARGS(); GET_TID();
                const int nscan = nb * 32, nqb = S / 256, natt = nb * 16 * nqb;
                const size_t gnx = grow + TCH;
                const float* xnext = (ch + 1 < NCHUNK) ? (ch + 1 < 4 ? a.x_p + gnx * DM : a.x_s + (gnx - NTOK_P) * DM) : (const float*)nullptr;
                float* oprev = (ch >= 1) ? a.out + (grow - TCH) * DM : (float*)nullptr;
#ifndef PROBE_MIX
#define PROBE_MIX 0
#endif
                for (int rep = 0; rep < (PROBE_MIX ? 2 : 1); ++rep)
                for (;;) {
                    if (tid == 0) misc[0] = atomicAdd(ctl + ch + 8 * rep, 1u);
                    __syncthreads(); unsigned u = misc[0]; __syncthreads();
                    if (rep == 1 && PROBE_MIX == 2) u += nscan;
                    if (rep == 1 && PROBE_MIX == 1 && u >= (unsigned)nscan) break;
                    if (u >= (unsigned)(nscan + natt)) break;
                    int tid_u = tid; asm volatile("" : "+v"(tid_u));
                    if (u < (unsigned)nscan) { const int ar = TCH / nscan;
                        cs::scan_unit(a, u >> 5, (u >> 1) & 15, u & 1, S, lds, tid_u, xnext, (bf16_t*)(ws + (((ch + 1) & 1) ? WS_XN1 : WS_XN)), oprev, (int)u * ar, ar); }
                    else { const int v = u - nscan, qb = v % nqb, hm = (v / nqb) & 15, b = v / (nqb * 16);
                        const size_t r0 = (size_t)b * S;
                        att::attn_body(H + (r0 + qb * 256) * PIN + C_Q + hm * 64, H + r0 * PIN + C_K + hm * 64, H + r0 * PIN + C_V + (hm >> 1) * 128,
                                       (bf16_t*)(ws + WS_ATT) + (r0 + qb * 256) * 2048 + hm * 128, S, (char*)lds_raw, tid_u); }
                }
            } else if (sub == 3) { if (!(PH_MASK & 16)) continue; LOAD_ARGS(); GET_TID();
                for (int rep = 0; rep < ((PROBE_DUP & 8) ? 2 : 1); ++rep) phase_post(a, gw, NGW, lane);
            } else if (sub == 4) { if (!(PH_MASK & 32)) continue; LOAD_ARGS(); GET_TID();
                {
                { pg8::Gemm g{(const bf16_t*)(ws + WS_OA), (const bf16_t*)(ws + WS_WOA), TCH, DM, 2048, 2048, 2048}; pg8::StaticOrder So; So.init(TCH, DM, G, bid, (PROBE_DUP & 16) ? 2 : 1);
                  EpiMix E{(bf16_t*)(ws + WS_M), H}; pg8::gemm_phase<2048, 2048>(lds, g, So, E, tid); } }
            } else { if (!(PH_MASK & 64)) continue; LOAD_ARGS(); GET_TID();
                { pg8::Gemm g{(const bf16_t*)(ws + WS_M), (const bf16_t*)(ws + WS_WOUT), TCH, DM, DM, DM, DM}; pg8::StaticOrder So; So.init(TCH, DM, G, bid, (PROBE_DUP & 32) ? 2 : 1);
                  const float* xc = ch < 4 ? a.x_p + grow * DM : a.x_s + (grow - NTOK_P) * DM; EpiOut E{a.out + grow * DM, xc}; pg8::gemm_phase<DM, DM>(lds, g, So, E, tid); }
                if (ch + 1 < NCHUNK) {
                    int tid2 = tid; asm volatile("" : "+v"(tid2));
                    pg8::Gemm g{(const bf16_t*)(ws + (((ch + 1) & 1) ? WS_XN1 : WS_XN)), (const bf16_t*)(ws + WS_WIN), TCH, PIN, DM, DM, DM}; pg8::StaticOrder So; So.init(TCH, PIN, G, bid);
                    EpiIn E{H, (bf16_t*)(ws + WS_LW), (const f32x4*)(ws + WS_ROPE), (ch + 1 < 4 ? 2048 : 4096) - 1}; pg8::gemm_phase<DM, DM>(lds, g, So, E, tid2); }
            }
        }
        if (p + 1 < ph_hi) {
            if (p == 0) grid.sync();
            else { int wv = wave0; asm volatile("" : "+s"(wv)); unsigned z3 = 0u; asm volatile("" : "+v"(z3));
                   const bool t0 = (wv == 0) && (__builtin_amdgcn_mbcnt_hi(~0u, __builtin_amdgcn_mbcnt_lo(~0u, z3)) == 0u);
                   xcd_barrier((unsigned*)(a_in.ws + WS_CTL) + 4096, misc + 8, t0, (unsigned)G0); }
        }
    }
}

extern "C" void kernel_launch(void* const* d_in, const int* in_sizes, int n_in, void* d_out, int out_size, void* d_ws, size_t ws_size, hipStream_t stream) {
    static int grid = 0;
    if (grid == 0) {
        if (n_in != 23 || ws_size < WS_END) { fprintf(stderr, "kernel_launch: unexpected n_in %d / ws %zu\n", n_in, ws_size); grid = -1; return; }
        int dev = 0, cus = 0, per_cu = 0;
        hipGetDevice(&dev); hipDeviceGetAttribute(&cus, hipDeviceAttributeMultiprocessorCount, dev);
        hipFuncSetAttribute((const void*)mega_fwd, hipFuncAttributeMaxDynamicSharedMemorySize, LDS_BYTES);
        hipOccupancyMaxActiveBlocksPerMultiprocessor(&per_cu, (const void*)mega_fwd, NTHR, LDS_BYTES);
        if (per_cu < 1) { fprintf(stderr, "kernel_launch: occupancy query says %d\n", per_cu); per_cu = 1; }
        grid = cus * 1;
    }
    if (grid < 0) return;
    if (hipMemsetAsync((char*)d_ws + WS_CTL, 0, 65536, stream) != hipSuccess) { fprintf(stderr, "kernel_launch: memset failed\n"); return; }
    Args a{};
    const float** f = (const float**)&a;
    for (int i = 0; i < 23; ++i) f[i] = (const float*)d_in[i];
    a.out = (float*)d_out; a.ws = (unsigned char*)d_ws; a.ph_lo = 0; a.ph_hi = N_PHASES;
    void* args[] = {&a};
    hipError_t e = hipLaunchCooperativeKernel((const void*)mega_fwd, dim3(grid), dim3(NTHR), args, LDS_BYTES, stream);
    if (e != hipSuccess) fprintf(stderr, "cooperative launch failed: %s (grid %d)\n", hipGetErrorString(e), grid);
}
```

```cpp
#include <hip/hip_runtime.h>
#include <hip/hip_bf16.h>
#include <hip/hip_cooperative_groups.h>
#include <cstdio>
#include <cstdint>
namespace cg = cooperative_groups;

constexpr int DM = 1024, PIN = 10496, TCH = 16384, NCHUNK = 6;
constexpr int NTOK_P = 32 * 2048, NTOK_S = 8 * 4096, NTOK = NTOK_P + NTOK_S;
constexpr int C_Q = 0, C_K = 1024, C_V = 2048, C_GA = 3072, C_RKV = 4096, C_GR = 7168, C_WL = 8192, C_GMA = 8448, C_GMB = 9472;
constexpr size_t MiB = 1u << 20;
constexpr size_t WS_CTL = 0;
constexpr size_t WS_WIN = 1 * MiB;
constexpr size_t WS_WOA = 22 * MiB, WS_WOR = 24 * MiB, WS_WOUT = 26 * MiB, WS_WLORA = 28 * MiB;
constexpr size_t WS_ROPE = 30 * MiB;
constexpr size_t WS_BONUS = 31 * MiB;
constexpr size_t WS_XN = 32 * MiB;
constexpr size_t WS_H = 64 * MiB;
constexpr size_t WS_CONV = 392 * MiB;
constexpr size_t WS_LORA = 520 * MiB;
constexpr size_t WS_ATT = 648 * MiB;
constexpr size_t WS_OF = 776 * MiB, WS_OB = 840 * MiB;
constexpr size_t WS_OA = 904 * MiB, WS_ORG = 936 * MiB;
constexpr size_t WS_M = 968 * MiB;
constexpr size_t WS_LW = 1000 * MiB;
constexpr size_t WS_XN1 = 808 * MiB;
constexpr size_t WS_END = 1008 * MiB;

#define LAS __attribute__((address_space(3)))
typedef unsigned short bf16_t;
typedef short bf16x8 __attribute__((ext_vector_type(8)));
typedef short s16x4 __attribute__((ext_vector_type(4)));
typedef float f32x4 __attribute__((ext_vector_type(4)));
typedef float f32x2 __attribute__((ext_vector_type(2)));
typedef float f32x8 __attribute__((ext_vector_type(8)));
typedef float f32x16 __attribute__((ext_vector_type(16)));
typedef unsigned u32x4 __attribute__((ext_vector_type(4)));
typedef unsigned u32x2 __attribute__((ext_vector_type(2)));

typedef __bf16 bf16x2_t __attribute__((ext_vector_type(2)));
__device__ __forceinline__ unsigned cvt_pk_bf16(float lo, float hi) { f32x2 v = {lo, hi}; bf16x2_t b = __builtin_convertvector(v, bf16x2_t); return __builtin_bit_cast(unsigned, b); }
__device__ __forceinline__ float bf_lo(unsigned w) { return __uint_as_float(w << 16); }
__device__ __forceinline__ float bf_hi(unsigned w) { return __uint_as_float(w & 0xffff0000u); }
__device__ __forceinline__ float bf1(bf16_t h) { return __uint_as_float(((unsigned)h) << 16); }
__device__ __forceinline__ float fsigmoid(float x) { return __builtin_amdgcn_rcpf(1.0f + __builtin_amdgcn_exp2f(-1.4426950408889634f * x)); }
__device__ __forceinline__ float ftanh(float x) { float t = __builtin_amdgcn_exp2f(2.8853900817779268f * x); return 1.0f - 2.0f * __builtin_amdgcn_rcpf(t + 1.0f); }
template <int CTRL> __device__ __forceinline__ float dpp_mov(float v) { return __builtin_bit_cast(float, __builtin_amdgcn_update_dpp(0, __builtin_bit_cast(int, v), CTRL, 0xf, 0xf, true)); }
__device__ __forceinline__ float allreduce16(float v) { v += dpp_mov<0xB1>(v); v += dpp_mov<0x4E>(v); v += dpp_mov<0x141>(v); v += dpp_mov<0x140>(v); return v; }
__device__ __forceinline__ float wave_sum(float v) {
    v = allreduce16(v);
    const int iv = __builtin_bit_cast(int, v);
    const float a = __builtin_bit_cast(float, __builtin_amdgcn_readlane(iv, 0)), b = __builtin_bit_cast(float, __builtin_amdgcn_readlane(iv, 16));
    const float c = __builtin_bit_cast(float, __builtin_amdgcn_readlane(iv, 32)), d = __builtin_bit_cast(float, __builtin_amdgcn_readlane(iv, 48));
    return (a + b) + (c + d);
}

namespace pg8 {
constexpr int BM = 256, BK = 64, HALF = 128, HTB = HALF * BK * 2, STAGE_BYTES = 8 * HTB, NXCD = 8, WGM = 4;
__host__ __device__ __forceinline__ int lds_byte(int r, int c) { const int st = (r >> 4) * 2 + (c >> 5), rr = r & 15, cc = c & 31, ob = rr * 64 + cc * 2; return st * 1024 + (ob ^ (((ob >> 9) & 1) << 5)); }
__host__ __device__ __forceinline__ void stage_rc(int b, int& R, int& C) { const int st = b / 1024, sb = b % 1024, swz = sb ^ (((sb >> 9) & 1) << 5); R = (st >> 1) * 16 + swz / 64; C = (st & 1) * 32 + (swz % 64) / 2; }
__host__ __device__ __forceinline__ int perm32(int rho) { const int n = rho >> 4, i = rho & 15; return 8 * (i >> 2) + 4 * n + (i & 3); }
struct Unit { int pm, pn; };
struct Gemm { const bf16_t* A; const bf16_t* Bt; int M, N, K, lda, ldb; };
struct StaticOrder {
    int nM, nN, nwg, G, c, reps;
    __device__ void init(int M, int N, int G_, int c_, int reps_ = 1) { nM = M / BM; nN = N / BM; nwg = nM * nN; G = G_; c = c_; reps = reps_; }
    __device__ bool next(int i, Unit& u) const {
        const long L = (long)i * G + c; if (L >= (long)nwg * reps) return false;
        int wgid = (int)(L % nwg); { const int q = nwg / NXCD, r = nwg % NXCD, xcd = wgid % NXCD, off = wgid / NXCD; wgid = (xcd < r ? xcd * (q + 1) : r * (q + 1) + (xcd - r) * q) + off; }
        const int nig = WGM * nN, gid = wgid / nig, fm = gid * WGM, gsz = (nM - fm) < WGM ? (nM - fm) : WGM;
        u.pm = fm + ((wgid % nig) % gsz); u.pn = (wgid % nig) / gsz; return true;
    }
};
template <class F> __device__ __forceinline__ void epi_foreach(const f32x4 (&acc)[2][2][4][2], const Unit& u, int wr, int wc, int fr, int fq, const F& f) {
    const int row0 = u.pm * BM + wr * 64 + fr, col0 = u.pn * BM + wc * 32 + 8 * fq;
#pragma unroll
    for (int ai = 0; ai < 2; ++ai)
#pragma unroll
        for (int m = 0; m < 4; ++m)
#pragma unroll
            for (int bj = 0; bj < 2; ++bj) { f(row0 + ai * HALF + m * 16, col0 + bj * HALF, acc[ai][bj][m][0], acc[ai][bj][m][1]); if ((m & 1) && bj) asm volatile("" ::: "memory"); }
}

template <class F> __device__ __forceinline__ void acc_foreach(f32x4 (&acc)[2][2][4][2], const Unit& u, int wr, int wc, int fr, int fq, const F& f) {
    const int row0 = u.pm * BM + wr * 64 + fr, col0 = u.pn * BM + wc * 32 + 8 * fq;
#pragma unroll
    for (int ai = 0; ai < 2; ++ai)
#pragma unroll
        for (int m = 0; m < 4; ++m)
#pragma unroll
            for (int bj = 0; bj < 2; ++bj) { f(row0 + ai * HALF + m * 16, col0 + bj * HALF, acc[ai][bj][m][0], acc[ai][bj][m][1]); if ((m & 1) && bj) asm volatile("" ::: "memory"); }
}
template <int LDA, int LDB, class Epi>
__device__ __forceinline__ void gemm_phase(LAS unsigned char* lds, const Gemm g, const StaticOrder& S, const Epi& E, const int tid) {
    const int wid = __builtin_amdgcn_readfirstlane(tid >> 6), lane = tid & 63, wr = wid >> 2, wc = wid & 3, fr = lane & 15, fq = lane >> 4;
    const int K = g.K, nt = K / BK;
    unsigned vofA[2], vofB[2];
    { int R, C; stage_rc(tid * 16, R, C); const int Rb = (R & ~31) + perm32(R & 31);
      vofA[0] = (unsigned)(R * LDA + C) * 2u; vofB[0] = (unsigned)(Rb * LDB + C) * 2u; vofA[1] = vofA[0] + 64u * LDA * 2u; vofB[1] = vofB[0] + 64u * LDB * 2u; }
    constexpr size_t kstep = (size_t)(BK * 2);
    constexpr size_t hstepA = (size_t)HALF * LDA * 2, hstepB = (size_t)HALF * LDB * 2;
    constexpr size_t tstepA = 2 * hstepA, tstepB = 2 * hstepB;
    const unsigned ldsw = (unsigned)wid * 1024u;
#define PG8_SA(b, h) (((b) * 2 + (h)) * HTB)
#define PG8_SB(b, h) ((4 + (b) * 2 + (h)) * HTB)
#define PG8_STAGE(bufoff, gbase, voff) do { _Pragma("unroll") for (int _i = 0; _i < 2; ++_i) \
        __builtin_amdgcn_global_load_lds((const unsigned*)((const char*)(gbase) + vof##voff[_i]), (LAS unsigned*)(lds + (bufoff) + ldsw + _i * 8192), 16, 0, 0); } while (0)
#define PG8_LDA(dst, b, h) do { _Pragma("unroll") for (int m = 0; m < 4; ++m) _Pragma("unroll") for (int k = 0; k < 2; ++k) dst[m][k] = *(const LAS bf16x8*)(lds + PG8_SA(b, h) + aoff + m * 2048 + k * 1024); } while (0)
#define PG8_LDB(dst, b, h) do { _Pragma("unroll") for (int n = 0; n < 2; ++n) _Pragma("unroll") for (int k = 0; k < 2; ++k) dst[n][k] = *(const LAS bf16x8*)(lds + PG8_SB(b, h) + boff + n * 2048 + k * 1024); } while (0)
#define PG8_MMA(ai, bj, At, Bt) do { __builtin_amdgcn_s_setprio(1); _Pragma("unroll") for (int m = 0; m < 4; ++m) _Pragma("unroll") for (int n = 0; n < 2; ++n) _Pragma("unroll") for (int k = 0; k < 2; ++k) \
        acc[ai][bj][m][n] = __builtin_amdgcn_mfma_f32_16x16x32_bf16(Bt[n][k], At[m][k], acc[ai][bj][m][n], 0, 0, 0); __builtin_amdgcn_s_setprio(0); } while (0)
#define PG8_WAIT_V(n) asm volatile("s_waitcnt vmcnt(" #n ")" ::: "memory")
#define PG8_WAIT_L(n) asm volatile("s_waitcnt lgkmcnt(" #n ")" ::: "memory")
#define PG8_BAR __builtin_amdgcn_s_barrier()
#define PG8_SCHED __builtin_amdgcn_sched_barrier(0)
    Unit cur, nxt; int ui = 0;
    if (!S.next(0, cur)) return;
    f32x4 acc[2][2][4][2];
#pragma unroll
    for (int a = 0; a < 2; ++a)
#pragma unroll
        for (int b = 0; b < 2; ++b)
#pragma unroll
            for (int m = 0; m < 4; ++m)
#pragma unroll
                for (int n = 0; n < 2; ++n) acc[a][b][m][n] = (f32x4){0.f, 0.f, 0.f, 0.f};
    bf16x8 At[4][2], B0[2][2], B1[2][2];
    const char* cA = (const char*)g.A + (size_t)cur.pm * tstepA; const char* cB = (const char*)g.Bt + (size_t)cur.pn * tstepB;
#define PG8_LAUNDER asm volatile("" : "+v"(vofA[0]), "+v"(vofA[1]), "+v"(vofB[0]), "+v"(vofB[1]))
    PG8_LAUNDER; PG8_STAGE(PG8_SB(0, 0), cB, B); PG8_LAUNDER; PG8_STAGE(PG8_SB(0, 1), cB + hstepB, B); PG8_LAUNDER; PG8_STAGE(PG8_SA(0, 0), cA, A); PG8_LAUNDER; PG8_STAGE(PG8_SA(0, 1), cA + hstepA, A);
    if (wr == 1) PG8_BAR;
    PG8_WAIT_V(2); PG8_BAR;
    PG8_LAUNDER; PG8_STAGE(PG8_SB(1, 0), cB + kstep, B); PG8_LAUNDER; PG8_STAGE(PG8_SA(1, 0), cA + kstep, A); PG8_LAUNDER; PG8_STAGE(PG8_SB(1, 1), cB + hstepB + kstep, B);
    PG8_WAIT_V(6); PG8_BAR; PG8_LAUNDER;
    for (;;) {
        unsigned zq_ = 0u; asm volatile("" : "+v"(zq_)); const int lq_ = (int)__builtin_amdgcn_mbcnt_hi(~0u, __builtin_amdgcn_mbcnt_lo(~0u, zq_));
        const int aoff = lds_byte(wr * 64 + (lq_ & 15), (lq_ >> 4) * 8), boff = lds_byte(wc * 32 + (lq_ & 15), (lq_ >> 4) * 8);
        const bool has_next = S.next(ui + 1, nxt);
        const char* nA = has_next ? (const char*)g.A + (size_t)nxt.pm * tstepA : cA; const char* nB = has_next ? (const char*)g.Bt + (size_t)nxt.pn * tstepB : cB;
        for (int half = 0; half < (Epi::HAS_MID ? 2 : 1); ++half) {
        if constexpr (Epi::HAS_MID) if (half == 1) { unsigned zm_ = 0u; asm volatile("" : "+v"(zm_)); const int lm_ = (int)__builtin_amdgcn_mbcnt_hi(~0u, __builtin_amdgcn_mbcnt_lo(~0u, zm_)); E.mid(acc, cur, wr, wc, lm_ & 15, lm_ >> 4); }
        const int t_lo = Epi::HAS_MID ? half * (nt / 2) : 0, t_hi = Epi::HAS_MID ? (half + 1) * (nt / 2) : nt;
        for (int t = t_lo; t < t_hi; t += 2) {
            const bool last = (t == nt - 2);
            const char* a1 = cA + (size_t)(t + 1) * kstep;
            const char* a2 = last ? nA : cA + (size_t)(t + 2) * kstep; const char* b2 = last ? nB : cB + (size_t)(t + 2) * kstep;
            const char* a3 = a2 + kstep; const char* b3 = b2 + kstep;
            PG8_LDB(B0, 0, 0); PG8_LDB(B1, 0, 1); PG8_SCHED; PG8_LDA(At, 0, 0); PG8_STAGE(PG8_SA(1, 1), a1 + hstepA, A);
            PG8_WAIT_V(8); PG8_WAIT_L(0); PG8_BAR; PG8_MMA(0, 0, At, B0); PG8_MMA(0, 1, At, B1); PG8_BAR; PG8_SCHED;
            PG8_LDA(At, 0, 1); PG8_STAGE(PG8_SB(0, 0), b2, B); PG8_STAGE(PG8_SB(0, 1), b2 + hstepB, B); PG8_STAGE(PG8_SA(0, 0), a2, A);
            PG8_WAIT_V(8); PG8_WAIT_L(0); PG8_BAR; PG8_MMA(1, 0, At, B0); PG8_MMA(1, 1, At, B1); PG8_BAR; PG8_SCHED;
            PG8_LDB(B0, 1, 0); PG8_LDB(B1, 1, 1); PG8_SCHED; PG8_LDA(At, 1, 0); PG8_STAGE(PG8_SA(0, 1), a2 + hstepA, A);
            PG8_WAIT_V(8); PG8_WAIT_L(0); PG8_BAR; PG8_MMA(0, 0, At, B0); PG8_MMA(0, 1, At, B1); PG8_BAR; PG8_SCHED;
            PG8_LDA(At, 1, 1); PG8_STAGE(PG8_SB(1, 0), b3, B); PG8_STAGE(PG8_SB(1, 1), b3 + hstepB, B); PG8_STAGE(PG8_SA(1, 0), a3, A);
            PG8_WAIT_V(8); PG8_WAIT_L(0); PG8_BAR; PG8_MMA(1, 0, At, B0); PG8_MMA(1, 1, At, B1); PG8_BAR; PG8_SCHED;
        }
        }
        if (wr == 0) PG8_BAR;
        { unsigned z_ = 0u; asm volatile("" : "+v"(z_)); const int ln_ = (int)__builtin_amdgcn_mbcnt_hi(~0u, __builtin_amdgcn_mbcnt_lo(~0u, z_)); E(acc, cur, wr, wc, ln_ & 15, ln_ >> 4); }
        if (!has_next) break;
#pragma unroll
        for (int a = 0; a < 2; ++a)
#pragma unroll
            for (int b = 0; b < 2; ++b)
#pragma unroll
                for (int m = 0; m < 4; ++m)
#pragma unroll
                    for (int n = 0; n < 2; ++n) acc[a][b][m][n] = (f32x4){0.f, 0.f, 0.f, 0.f};
        cur = nxt; cA = nA; cB = nB; ++ui;
        if (wr == 1) PG8_BAR;
    }
    PG8_WAIT_V(0);
    PG8_BAR;
#undef PG8_SA
#undef PG8_SB
#undef PG8_STAGE
#undef PG8_LDA
#undef PG8_LDB
#undef PG8_MMA
#undef PG8_WAIT_V
#undef PG8_WAIT_L
#undef PG8_BAR
#undef PG8_SCHED
}
}

__device__ __forceinline__ u32x4 pack8(f32x4 v0, f32x4 v1) { u32x4 w; w.x = cvt_pk_bf16(v0[0], v0[1]); w.y = cvt_pk_bf16(v0[2], v0[3]); w.z = cvt_pk_bf16(v1[0], v1[1]); w.w = cvt_pk_bf16(v1[2], v1[3]); return w; }
__device__ __forceinline__ void unpack8(u32x4 w, float* f) { f[0] = bf_lo(w.x); f[1] = bf_hi(w.x); f[2] = bf_lo(w.y); f[3] = bf_hi(w.y); f[4] = bf_lo(w.z); f[5] = bf_hi(w.z); f[6] = bf_lo(w.w); f[7] = bf_hi(w.w); }

struct EpiIn {
    static constexpr bool HAS_MID = false;
    bf16_t* H; bf16_t* LW; const f32x4* RT; int smask;
    __device__ __forceinline__ void operator()(const f32x4 (&acc)[2][2][4][2], const pg8::Unit& u, int wr, int wc, int fr, int fq) const {
        const bool lt = (u.pn == C_WL / 256), qk = (u.pn < 8);
        bf16_t* base = lt ? LW - C_WL : H; const size_t pitch = lt ? 256 : PIN;
        const f32x4* rt = RT; const int sm = smask;
        pg8::epi_foreach(acc, u, wr, wc, fr, fq, [&](int row, int col, f32x4 v0, f32x4 v1) {
            if (lt && col < C_WL + 128) {
#pragma unroll
                for (int i = 0; i < 4; ++i) { v0[i] = ftanh(v0[i]); v1[i] = ftanh(v1[i]); }
            }
            if (qk && (col & 63) < 16) {
                const f32x4 c0 = rt[(row & sm) * 4 + ((col >> 3) & 1) * 2], c1 = rt[(row & sm) * 4 + ((col >> 3) & 1) * 2 + 1];
                const f32x4 x1 = v0, x2 = v1;
                v0 = (f32x4){x1[0] * c0[0] - x2[0] * c0[1], x1[1] * c0[2] - x2[1] * c0[3], x1[2] * c1[0] - x2[2] * c1[1], x1[3] * c1[2] - x2[3] * c1[3]};
                v1 = (f32x4){x2[0] * c0[0] + x1[0] * c0[1], x2[1] * c0[2] + x1[1] * c0[3], x2[2] * c1[0] + x1[2] * c1[1], x2[3] * c1[2] + x1[3] * c1[3]};
            }
            *(u32x4*)(base + (size_t)row * pitch + col) = pack8(v0, v1); });
    }
};
struct EpiLora {
    static constexpr bool HAS_MID = false;
    bf16_t* O; const float* w0; const float* a0;
    __device__ __forceinline__ void operator()(const f32x4 (&acc)[2][2][4][2], const pg8::Unit& u, int wr, int wc, int fr, int fq) const {
        bf16_t* Oo = O; const bool isw = (u.pn < 8); const float* bias = isw ? w0 : a0;
        pg8::epi_foreach(acc, u, wr, wc, fr, fq, [&](int row, int col, f32x4 v0, f32x4 v1) {
            const int bc = col & 2047;
            const f32x4 b0 = *(const f32x4*)(bias + bc), b1 = *(const f32x4*)(bias + bc + 4);
#pragma unroll
            for (int i = 0; i < 4; ++i) {
                float z0 = v0[i] + b0[i], z1 = v1[i] + b1[i];
                if (isw) { const float e0 = 0.6065306597126334f * fsigmoid(z0), e1 = 0.6065306597126334f * fsigmoid(z1);
                    v0[i] = 1.0f - __builtin_amdgcn_exp2f(-1.4426950408889634f * e0); v1[i] = 1.0f - __builtin_amdgcn_exp2f(-1.4426950408889634f * e1); }
                else { v0[i] = fsigmoid(z0); v1[i] = fsigmoid(z1); }
            }
            *(u32x4*)(Oo + (size_t)row * 4096 + col) = pack8(v0, v1); });
    }
};
struct EpiMa {
    static constexpr bool HAS_MID = false;
    float* MA; const bf16_t* H; int gcol;
    __device__ __forceinline__ void operator()(const f32x4 (&acc)[2][2][4][2], const pg8::Unit& u, int wr, int wc, int fr, int fq) const {
        float* Mm = MA; const bf16_t* Hh = H; const int gc = gcol;
        pg8::epi_foreach(acc, u, wr, wc, fr, fq, [&](int row, int col, f32x4 v0, f32x4 v1) {
            float gt[8]; unpack8(*(const u32x4*)(Hh + (size_t)row * PIN + gc + col), gt);
#pragma unroll
            for (int i = 0; i < 4; ++i) { v0[i] *= fsigmoid(gt[i]); v1[i] *= fsigmoid(gt[4 + i]); }
            float* p = Mm + (size_t)row * DM + col; *(f32x4*)p = v0; *(f32x4*)(p + 4) = v1; });
    }
};
struct EpiM {
    static constexpr bool HAS_MID = false;
    bf16_t* M; const float* MA; const bf16_t* H; int gcol;
    __device__ __forceinline__ void operator()(const f32x4 (&acc)[2][2][4][2], const pg8::Unit& u, int wr, int wc, int fr, int fq) const {
        bf16_t* Mo = M; const float* Mm = MA; const bf16_t* Hh = H; const int gc = gcol;
        pg8::epi_foreach(acc, u, wr, wc, fr, fq, [&](int row, int col, f32x4 v0, f32x4 v1) {
            float gt[8]; unpack8(*(const u32x4*)(Hh + (size_t)row * PIN + gc + col), gt);
            const float* p = Mm + (size_t)row * DM + col; const f32x4 m0 = *(const f32x4*)p, m1 = *(const f32x4*)(p + 4);
#pragma unroll
            for (int i = 0; i < 4; ++i) { v0[i] = m0[i] + v0[i] * fsigmoid(gt[i]); v1[i] = m1[i] + v1[i] * fsigmoid(gt[4 + i]); }
            *(u32x4*)(Mo + (size_t)row * DM + col) = pack8(v0, v1); });
    }
};
struct EpiMix {
    static constexpr bool HAS_MID = true;
    bf16_t* M; const bf16_t* H;
    __device__ __forceinline__ void mid(f32x4 (&acc)[2][2][4][2], const pg8::Unit& u, int wr, int wc, int fr, int fq) const {
        const bf16_t* Hh = H;
        pg8::acc_foreach(acc, u, wr, wc, fr, fq, [&](int row, int col, f32x4& v0, f32x4& v1) {
            float ga[8], gb[8]; unpack8(*(const u32x4*)(Hh + (size_t)row * PIN + C_GMA + col), ga); unpack8(*(const u32x4*)(Hh + (size_t)row * PIN + C_GMB + col), gb);
#pragma unroll
            for (int i = 0; i < 4; ++i) {
                v0[i] *= (1.0f + __builtin_amdgcn_exp2f(-1.4426950408889634f * gb[i])) * __builtin_amdgcn_rcpf(1.0f + __builtin_amdgcn_exp2f(-1.4426950408889634f * ga[i]));
                v1[i] *= (1.0f + __builtin_amdgcn_exp2f(-1.4426950408889634f * gb[4 + i])) * __builtin_amdgcn_rcpf(1.0f + __builtin_amdgcn_exp2f(-1.4426950408889634f * ga[4 + i])); } });
    }
    __device__ __forceinline__ void operator()(const f32x4 (&acc)[2][2][4][2], const pg8::Unit& u, int wr, int wc, int fr, int fq) const {
        bf16_t* Mo = M; const bf16_t* Hh = H;
        pg8::epi_foreach(acc, u, wr, wc, fr, fq, [&](int row, int col, f32x4 v0, f32x4 v1) {
            float gb[8]; unpack8(*(const u32x4*)(Hh + (size_t)row * PIN + C_GMB + col), gb);
#pragma unroll
            for (int i = 0; i < 4; ++i) { v0[i] *= fsigmoid(gb[i]); v1[i] *= fsigmoid(gb[4 + i]); }
            *(u32x4*)(Mo + (size_t)row * DM + col) = pack8(v0, v1); });
    }
};
struct EpiOut {
    static constexpr bool HAS_MID = false;
    float* out; const float* x;
    __device__ __forceinline__ void operator()(const f32x4 (&acc)[2][2][4][2], const pg8::Unit& u, int wr, int wc, int fr, int fq) const {
        float* oo = out; const float* xx = x;
        pg8::epi_foreach(acc, u, wr, wc, fr, fq, [&](int row, int col, f32x4 v0, f32x4 v1) {
            const size_t off = (size_t)row * DM + col;
            const f32x4 x0 = __builtin_nontemporal_load((const f32x4*)(xx + off)), x1 = __builtin_nontemporal_load((const f32x4*)(xx + off + 4));
            *(f32x4*)(oo + off) = v0 + x0; *(f32x4*)(oo + off + 4) = v1 + x1; });
    }
};

struct Args {
    const float* x_p; const float* x_s; const float* norm_g; const float* w_in; const float* conv; const float* lq1; const float* lk1; const float* lq2; const float* lk2;
    const float* subln_g; const float* wlu; const float* w0; const float* alu; const float* a0; const float* k_k; const float* k_a; const float* r_k; const float* lnx_g; const float* lnx_b;
    const float* w_oa; const float* w_or; const float* w_out; const float* final_g;
    float* out; unsigned char* ws; int ph_lo, ph_hi;
};
constexpr int NWAVES = 8, NTHR = 512;
constexpr int LDS_BYTES = 147456;

__device__ __forceinline__ void p0_transpose_item(const float* W, int K, int N, bf16_t* WT, LAS float* scr, int item, int lane, const int ldwt, const int koff, const bool ropeperm = false) {
    const int nblk = N / 32, kb = item / nblk, nb = item % nblk, k0 = 64 * kb, n0 = 32 * nb;
    int nsrc = n0 + (lane & 31);
    if (ropeperm && nsrc < 2048 && (nsrc & 63) < 16) { const int d = nsrc & 15; nsrc = (nsrc & ~15) | ((d & 3) | (((d >> 2) & 1) << 3) | (((d >> 3) & 1) << 2)); }
#pragma unroll 8
    for (int i = 0; i < 32; ++i) { const int kk = 2 * i + (lane >> 5); scr[kk * 33 + (lane & 31)] = W[(size_t)(k0 + kk) * N + nsrc]; }
    asm volatile("s_waitcnt lgkmcnt(0)" ::: "memory");
    const int c = lane & 7;
#pragma unroll
    for (int j = 0; j < 4; ++j) { const int n = (lane >> 3) + 8 * j; const LAS float* s = scr + (8 * c) * 33 + n;
        u32x4 o; o.x = cvt_pk_bf16(s[0 * 33], s[1 * 33]); o.y = cvt_pk_bf16(s[2 * 33], s[3 * 33]); o.z = cvt_pk_bf16(s[4 * 33], s[5 * 33]); o.w = cvt_pk_bf16(s[6 * 33], s[7 * 33]);
        *(u32x4*)(WT + (size_t)(n0 + n) * ldwt + koff + k0 + 8 * c) = o; }
    asm volatile("s_waitcnt lgkmcnt(0)" ::: "memory");
}

__device__ __forceinline__ void phase_weights(const Args& a, LAS unsigned char* lds, int gw, int NGW, int lane, int wave) {
    unsigned char* ws = a.ws;
    LAS float* scr = (LAS float*)(lds + wave * 16384);
    constexpr int I_IN = (DM / 64) * (PIN / 32), I_SQ = (DM / 64) * (DM / 32);
    for (int it = gw; it < I_IN + 3 * I_SQ; it += NGW) {
        int r = it;
        if (r < I_IN) { p0_transpose_item(a.w_in, DM, PIN, (bf16_t*)(ws + WS_WIN), scr, r, lane, DM, 0, true); continue; } r -= I_IN;
        if (r < I_SQ) { p0_transpose_item(a.w_oa, DM, DM, (bf16_t*)(ws + WS_WOA), scr, r, lane, 2048, 0); continue; } r -= I_SQ;
        if (r < I_SQ) { p0_transpose_item(a.w_or, DM, DM, (bf16_t*)(ws + WS_WOA), scr, r, lane, 2048, 1024); continue; } r -= I_SQ;
        p0_transpose_item(a.w_out, DM, DM, (bf16_t*)(ws + WS_WOUT), scr, r, lane, DM, 0);
    }
    bf16_t* WL = (bf16_t*)(ws + WS_WLORA);
    for (int e = gw * 64 + lane; e < 4096 * 256; e += NGW * 64) {
        const int n = e >> 8, k = e & 255, kind = n >> 10, ch = n & 1023, j = k - 64 * kind;
        float v = 0.f;
        if (j >= 0 && j < 64) { const float* src = (kind < 2) ? a.wlu : a.alu; v = src[((size_t)(kind & 1) * 64 + j) * 1024 + ch]; }
        WL[e] = (bf16_t)(cvt_pk_bf16(v, 0.f) & 0xffffu);
    }
    f32x2* RT = (f32x2*)(ws + WS_ROPE);
    for (int e = gw * 64 + lane; e < 4096 * 8; e += NGW * 64) {
        const int pos = e >> 3, i = e & 7;
        const float inv = exp2f(-(float)i * (0.125f * 18.931568569324174f));
        const float ang = (float)pos * inv;
        const float n = rintf(ang * 0.15915494309189535f);
        float r = fmaf(-n, 6.28125f, ang); r = fmaf(-n, 1.9353071795864769e-3f, r);
        RT[e] = (f32x2){__cosf(r), __sinf(r)};
    }
}

__device__ __forceinline__ void phase_xn(const float* x, const float* g, bf16_t* XN, int nrows, int gw, int NGW, int lane) {
    f32x4 gv[4];
#pragma unroll
    for (int j = 0; j < 4; ++j) gv[j] = ((const f32x4*)g)[lane + 64 * j];
    for (int m = gw; m < nrows; m += NGW) {
        const f32x4* xr = (const f32x4*)(x + (size_t)m * DM) + lane;
        f32x4 v[4]; float s = 0.f;
#pragma unroll
        for (int j = 0; j < 4; ++j) { v[j] = __builtin_nontemporal_load(xr + 64 * j); s += (v[j].x * v[j].x + v[j].y * v[j].y) + (v[j].z * v[j].z + v[j].w * v[j].w); }
        const float rstd = 1.0f / sqrtf(wave_sum(s) * (1.f / DM) + 1e-6f);
        u32x2* o8 = (u32x2*)(XN + (size_t)m * DM) + lane;
#pragma unroll
        for (int j = 0; j < 4; ++j) { u32x2 w; w.x = cvt_pk_bf16(v[j].x * rstd * gv[j].x, v[j].y * rstd * gv[j].y); w.y = cvt_pk_bf16(v[j].z * rstd * gv[j].z, v[j].w * rstd * gv[j].w); o8[64 * j] = w; }
    }
}
__device__ __forceinline__ void phase_final(float* out, const float* g, int nrows, int gw, int NGW, int lane) {
    f32x4 gv[4];
#pragma unroll
    for (int j = 0; j < 4; ++j) gv[j] = ((const f32x4*)g)[lane + 64 * j];
    for (int m = gw; m < nrows; m += NGW) {
        f32x4* xr = (f32x4*)(out + (size_t)m * DM) + lane;
        f32x4 v[4]; float s = 0.f;
#pragma unroll
        for (int j = 0; j < 4; ++j) { v[j] = __builtin_nontemporal_load(xr + 64 * j); s += (v[j].x * v[j].x + v[j].y * v[j].y) + (v[j].z * v[j].z + v[j].w * v[j].w); }
        const float rstd = 1.0f / sqrtf(wave_sum(s) * (1.f / DM) + 1e-6f);
#pragma unroll
        for (int j = 0; j < 4; ++j) __builtin_nontemporal_store(v[j] * rstd * gv[j], xr + 64 * j);
    }
}

__device__ __forceinline__ f32x4 unp4(u32x2 w) { return (f32x4){bf_lo(w.x), bf_hi(w.x), bf_lo(w.y), bf_hi(w.y)}; }
__device__ __forceinline__ u32x2 pk4(f32x4 v) { u32x2 w; w.x = cvt_pk_bf16(v[0], v[1]); w.y = cvt_pk_bf16(v[2], v[3]); return w; }
__device__ __forceinline__ void phase_prep(const Args& a, int S, int gw, int NGW, int lane, const bool do_rope) {
    unsigned char* ws = a.ws;
    bf16_t* H = (bf16_t*)(ws + WS_H); bf16_t* CV = (bf16_t*)(ws + WS_CONV); float* BN = (float*)(ws + WS_BONUS);
    const f32x4* RT = (const f32x4*)(ws + WS_ROPE);
    if (do_rope)
    for (int it = gw * 64 + lane; it < TCH * 32; it += NGW * 64) {
        const int t = it >> 5, grp = it & 31, pos = t % S;
        bf16_t* p = H + (size_t)t * PIN + grp * 64;
        const u32x4 w1 = *(const u32x4*)p, w2 = *(const u32x4*)(p + 8);
        float x1[8], x2[8], y1[8], y2[8]; unpack8(w1, x1); unpack8(w2, x2);
#pragma unroll
        for (int j = 0; j < 4; ++j) { const f32x4 cs = RT[pos * 4 + j];
            y1[2 * j] = x1[2 * j] * cs[0] - x2[2 * j] * cs[1]; y2[2 * j] = x2[2 * j] * cs[0] + x1[2 * j] * cs[1];
            y1[2 * j + 1] = x1[2 * j + 1] * cs[2] - x2[2 * j + 1] * cs[3]; y2[2 * j + 1] = x2[2 * j + 1] * cs[2] + x1[2 * j + 1] * cs[3]; }
        *(u32x4*)p = pack8((f32x4){y1[0], y1[1], y1[2], y1[3]}, (f32x4){y1[4], y1[5], y1[6], y1[7]});
        *(u32x4*)(p + 8) = pack8((f32x4){y2[0], y2[1], y2[2], y2[3]}, (f32x4){y2[4], y2[5], y2[6], y2[7]});
    }
    {
        const int hd = 8 * (gw & 1) + (lane >> 3), c8 = 8 * (lane & 7), hc = hd * 64 + c8;
        f32x4 cw[3][3][2];
#pragma unroll
        for (int part = 0; part < 3; ++part)
#pragma unroll
            for (int i = 0; i < 3; ++i) { cw[part][i][0] = *(const f32x4*)(a.conv + i * 3072 + part * 1024 + hc); cw[part][i][1] = *(const f32x4*)(a.conv + i * 3072 + part * 1024 + hc + 4); }
        const f32x4 kw0 = *(const f32x4*)(a.k_k + hc), kw1 = *(const f32x4*)(a.k_k + hc + 4), rw0 = *(const f32x4*)(a.r_k + hc), rw1 = *(const f32x4*)(a.r_k + hc + 4);
        for (int t0 = gw >> 1; t0 < TCH; t0 += NGW) {
            u32x4 raw[2][3][3];
#pragma unroll
            for (int e = 0; e < 2; ++e) { const int t = t0 + e * (NGW >> 1); if (t >= TCH) continue;
                const int pos = t % S; const bool hasp = pos > 0, hasn = pos < S - 1;
                const bf16_t* hr = H + (size_t)t * PIN + C_RKV + hc;
#pragma unroll
                for (int part = 0; part < 3; ++part) {
                    raw[e][part][1] = *(const u32x4*)(hr + part * 1024);
                    raw[e][part][0] = hasp ? *(const u32x4*)(hr + part * 1024 - PIN) : (u32x4){0u, 0u, 0u, 0u};
                    raw[e][part][2] = hasn ? *(const u32x4*)(hr + part * 1024 + PIN) : (u32x4){0u, 0u, 0u, 0u}; } }
#pragma unroll
            for (int e = 0; e < 2; ++e) { const int t = t0 + e * (NGW >> 1); if (t >= TCH) continue;
                float rkv[3][8];
#pragma unroll
                for (int part = 0; part < 3; ++part) {
                    float xm[8], x0[8], xp[8]; unpack8(raw[e][part][0], xm); unpack8(raw[e][part][1], x0); unpack8(raw[e][part][2], xp);
#pragma unroll
                    for (int i = 0; i < 8; ++i) { const float w0 = cw[part][0][i >> 2][i & 3], w1 = cw[part][1][i >> 2][i & 3], w2 = cw[part][2][i >> 2][i & 3];
                        rkv[part][i] = fmaf(xp[i], w2, fmaf(xm[i], w0, x0[i] * w1)); }
                }
                float kk[8], ss = 0.f, bs = 0.f;
#pragma unroll
                for (int i = 0; i < 8; ++i) { kk[i] = rkv[1][i] * (i < 4 ? kw0[i] : kw1[i - 4]); ss = fmaf(kk[i], kk[i], ss); bs = fmaf(rkv[0][i] * rkv[1][i], (i < 4 ? rw0[i] : rw1[i - 4]), bs); }
                ss += dpp_mov<0xB1>(ss); ss += dpp_mov<0x4E>(ss); ss += dpp_mov<0x141>(ss);
                bs += dpp_mov<0xB1>(bs); bs += dpp_mov<0x4E>(bs); bs += dpp_mov<0x141>(bs);
                const float rn = 1.0f / sqrtf(ss + 1e-12f);
                bf16_t* o = CV + ((size_t)t * 16 + hd) * 256 + c8;
                *(u32x4*)o = pack8((f32x4){rkv[0][0], rkv[0][1], rkv[0][2], rkv[0][3]}, (f32x4){rkv[0][4], rkv[0][5], rkv[0][6], rkv[0][7]});
                *(u32x4*)(o + 64) = pack8((f32x4){rkv[1][0], rkv[1][1], rkv[1][2], rkv[1][3]}, (f32x4){rkv[1][4], rkv[1][5], rkv[1][6], rkv[1][7]});
                *(u32x4*)(o + 128) = pack8((f32x4){rkv[2][0], rkv[2][1], rkv[2][2], rkv[2][3]}, (f32x4){rkv[2][4], rkv[2][5], rkv[2][6], rkv[2][7]});
                *(u32x4*)(o + 192) = pack8((f32x4){kk[0] * rn, kk[1] * rn, kk[2] * rn, kk[3] * rn}, (f32x4){kk[4] * rn, kk[5] * rn, kk[6] * rn, kk[7] * rn});
                if ((lane & 7) == 0) BN[t * 16 + hd] = bs; }
        }
    }
}
namespace att {
constexpr int NW = 8, QBLK = 32, KVBLK = 64;
constexpr float SCALE = 0.125f, THR = 8.f;
constexpr int LDK = PIN, LDO = 2048;
constexpr int SHM_V = KVBLK * 128 * 2, SHM_K = KVBLK * 64 * 2, SHM_ATTN = 2 * SHM_V + 2 * SHM_K + NW * 64 * 4;
#define KSWZ(row, colB) ((row) * 128 + ((colB) ^ (((row) & 7) << 4)))
#define SBAR() __builtin_amdgcn_sched_barrier(0)
__device__ __forceinline__ int crow(int r, int hi) { return (r & 3) + 8 * (r >> 2) + 4 * hi; }
__device__ __forceinline__ void partialSM(f32x16& p0, f32x16& p1, float& m_reg, float& mn, float& alpha) {
  constexpr float C = SCALE * 1.4426950408889634f;
  float pmax = p0[0];
#pragma unroll
  for (int r = 1; r < 16; ++r) pmax = fmaxf(pmax, p0[r]);
#pragma unroll
  for (int r = 0; r < 16; ++r) pmax = fmaxf(pmax, p1[r]);
  { auto rr = __builtin_amdgcn_permlane32_swap(__float_as_uint(pmax), __float_as_uint(pmax), false, false);
    pmax = fmaxf(__uint_as_float(rr[0]), __uint_as_float(rr[1])); }
  if (__builtin_expect(__all(pmax - m_reg <= THR / SCALE), 1)) { mn = m_reg; alpha = 1.f; }
  else { mn = fmaxf(m_reg, pmax); alpha = __builtin_amdgcn_exp2f((m_reg - mn) * C); m_reg = mn; }
  float mnC = -mn * C;
#pragma unroll
  for (int r = 0; r < 16; ++r) p0[r] = fmaf(p0[r], C, mnC);
#pragma unroll
  for (int r = 0; r < 16; ++r) p1[r] = fmaf(p1[r], C, mnC);
#pragma unroll
  for (int r = 0; r < 16; ++r) p0[r] = __builtin_amdgcn_exp2f(p0[r]);
}
__device__ __forceinline__ void finishSM(f32x16& p0, f32x16& p1, float alpha, float& l_reg, bf16x8& pa0, bf16x8& pa1, bf16x8& pa2, bf16x8& pa3) {
#pragma unroll
  for (int r = 0; r < 16; ++r) p1[r] = __builtin_amdgcn_exp2f(p1[r]);
  float ps = 0;
#pragma unroll
  for (int r = 0; r < 16; ++r) ps += p0[r];
#pragma unroll
  for (int r = 0; r < 16; ++r) ps += p1[r];
  { auto rr = __builtin_amdgcn_permlane32_swap(__float_as_uint(ps), __float_as_uint(ps), false, false);
    ps = __uint_as_float(rr[0]) + __uint_as_float(rr[1]); }
  l_reg = l_reg * alpha + ps;
#define PK4(P, BASE, OUT) do { unsigned a0 = cvt_pk_bf16(P[BASE + 0], P[BASE + 1]), a1 = cvt_pk_bf16(P[BASE + 2], P[BASE + 3]);   \
    unsigned b0 = cvt_pk_bf16(P[BASE + 4], P[BASE + 5]), b1 = cvt_pk_bf16(P[BASE + 6], P[BASE + 7]);                              \
    auto r0 = __builtin_amdgcn_permlane32_swap(a0, b0, false, false); auto r1 = __builtin_amdgcn_permlane32_swap(a1, b1, false, false); \
    u32x4 w = {r0[0], r1[0], r0[1], r1[1]}; OUT = *reinterpret_cast<bf16x8*>(&w); } while (0)
  PK4(p0, 0, pa0); PK4(p0, 8, pa1); PK4(p1, 0, pa2); PK4(p1, 8, pa3);
#undef PK4
}
__device__ __forceinline__ void qkt(f32x16& p0, f32x16& p1, const char* Ks, const bf16x8* qr, int r32, int hi) {
  p0 = f32x16{}; p1 = f32x16{};
#pragma unroll
  for (int d0 = 0; d0 < 4; ++d0) { int cb = (d0 * 16 + hi * 8) * 2;
    bf16x8 b0 = *reinterpret_cast<const bf16x8*>(Ks + KSWZ(r32, cb));
    bf16x8 b1 = *reinterpret_cast<const bf16x8*>(Ks + KSWZ(32 + r32, cb));
    p0 = __builtin_amdgcn_mfma_f32_32x32x16_bf16(b0, qr[d0], p0, 0, 0, 0);
    p1 = __builtin_amdgcn_mfma_f32_32x32x16_bf16(b1, qr[d0], p1, 0, 0, 0); }
}
__device__ __forceinline__ int v_st(int k, int c) { const int kk = (k & ~0xC) | ((k & 4) << 1) | ((k & 8) >> 1); return ((kk >> 3) * 4 + (c >> 5)) * 512 + ((kk & 7) * 32 + (c & 31)) * 2; }
__device__ __forceinline__ int v_rd_base(int lane) { return ((lane & 3) << 3) | (((lane >> 2) & 3) << 6) | (((lane >> 4) & 1) << 5) | (((lane >> 5) & 1) << 8); }
constexpr int v_rd_off(int d0, int ks, int half) { return d0 * 512 + ks * 4096 + half * 2048; }
template <int OFF> __device__ __forceinline__ s16x4 tr_read(int vb) {
  s16x4 r; asm volatile("ds_read_b64_tr_b16 %0, %1 offset:%2" : "=&v"(r) : "v"(vb), "i"(OFF) : "memory"); return r;
}
template <int D0> __device__ __forceinline__ void pv_one(f32x16& od, int vb, bf16x8 pa0, bf16x8 pa1, bf16x8 pa2, bf16x8 pa3) {
  const s16x4 l0 = tr_read<v_rd_off(D0, 0, 0)>(vb), h0 = tr_read<v_rd_off(D0, 0, 1)>(vb), l1 = tr_read<v_rd_off(D0, 1, 0)>(vb), h1 = tr_read<v_rd_off(D0, 1, 1)>(vb);
  const s16x4 l2 = tr_read<v_rd_off(D0, 2, 0)>(vb), h2 = tr_read<v_rd_off(D0, 2, 1)>(vb), l3 = tr_read<v_rd_off(D0, 3, 0)>(vb), h3 = tr_read<v_rd_off(D0, 3, 1)>(vb);
  asm volatile("s_waitcnt lgkmcnt(0)" ::: "memory"); SBAR();
#define PK(L, H) (bf16x8){L[0], L[1], L[2], L[3], H[0], H[1], H[2], H[3]}
  od = __builtin_amdgcn_mfma_f32_32x32x16_bf16(pa0, PK(l0, h0), od, 0, 0, 0);
  od = __builtin_amdgcn_mfma_f32_32x32x16_bf16(pa1, PK(l1, h1), od, 0, 0, 0);
  od = __builtin_amdgcn_mfma_f32_32x32x16_bf16(pa2, PK(l2, h2), od, 0, 0, 0);
  od = __builtin_amdgcn_mfma_f32_32x32x16_bf16(pa3, PK(l3, h3), od, 0, 0, 0);
#undef PK
}
__device__ __forceinline__ void pv_d0(f32x16* o, int vb, bf16x8 pa0, bf16x8 pa1, bf16x8 pa2, bf16x8 pa3) {
  pv_one<0>(o[0], vb, pa0, pa1, pa2, pa3); pv_one<1>(o[1], vb, pa0, pa1, pa2, pa3); pv_one<2>(o[2], vb, pa0, pa1, pa2, pa3); pv_one<3>(o[3], vb, pa0, pa1, pa2, pa3);
}
__device__ __forceinline__ void attn_body(const bf16_t* __restrict__ Qb, const bf16_t* __restrict__ Kh, const bf16_t* __restrict__ Vh,
                                          bf16_t* __restrict__ Ob, int seq, char* lds, const int tid) {
  const int wid = tid >> 6, lane = tid & 63, r32 = lane & 31, hi = lane >> 5;
  char* V_lds = lds; char* K_lds = lds + 2 * SHM_V;
  float* ws = (float*)(lds + 2 * SHM_V + 2 * SHM_K) + wid * 64; float* li_l = ws; float* al_l = ws + 32;
  float m_reg = -1e30f, l_reg = 0; f32x16 o[4] = {}; bf16x8 qr[4];
  const bf16_t* Qw = Qb + (long)(wid * QBLK + r32) * LDK + hi * 8;
#pragma unroll
  for (int d0 = 0; d0 < 4; ++d0) qr[d0] = *reinterpret_cast<const bf16x8*>(Qw + d0 * 16);
  const int sr = tid >> 4, sc = (tid & 15) * 8, vst0 = v_st(sr, sc), vst1 = v_st(32 + sr, sc);
  const int kr = tid >> 3, kc = (tid & 7) * 8, kst = KSWZ(kr, kc * 2);
  const int vb0 = (int)(uintptr_t)V_lds + v_rd_base(lane);
  struct { bf16x8 vs0, vs1, ks0; } sr_[2];
  const unsigned vo0 = (unsigned)(sr * LDK + sc), vo1 = (unsigned)((32 + sr) * LDK + sc), ko0 = (unsigned)(kr * LDK + kc);
#define SLOAD(i, k0) do { const bf16_t* Vt_ = Vh + (size_t)(k0) * LDK; const bf16_t* Kt_ = Kh + (size_t)(k0) * LDK; \
    sr_[i].vs0 = *reinterpret_cast<const bf16x8*>(Vt_ + vo0); sr_[i].vs1 = *reinterpret_cast<const bf16x8*>(Vt_ + vo1); \
    sr_[i].ks0 = *reinterpret_cast<const bf16x8*>(Kt_ + ko0); } while (0)
#define SWRITE(b, i) do { *(bf16x8*)(V_lds + (b) * SHM_V + vst0) = sr_[i].vs0; *(bf16x8*)(V_lds + (b) * SHM_V + vst1) = sr_[i].vs1; \
    *(bf16x8*)(K_lds + (b) * SHM_K + kst) = sr_[i].ks0; } while (0)
#define SWAIT() asm volatile("s_waitcnt vmcnt(3)" ::: "memory")
#define RESC(a) do { if (__any((a) < 1.f)) { if (hi == 0) al_l[r32] = (a); asm volatile("s_waitcnt lgkmcnt(0)" ::: "memory"); \
    _Pragma("unroll") for (int d = 0; d < 4; ++d) _Pragma("unroll") for (int r = 0; r < 16; ++r) o[d][r] *= al_l[crow(r, hi)]; } } while (0)
  f32x16 pA0, pA1, pB0, pB1; float mnA, mnB, alA, alB; bf16x8 pa0, pa1, pa2, pa3; const int NT = seq / KVBLK;
  constexpr int SE = 0, SO = 1;
  SLOAD(SE, 0); asm volatile("s_waitcnt vmcnt(0)" ::: "memory"); SWRITE(0, SE); __syncthreads();
  qkt(pA0, pA1, K_lds, qr, r32, hi); partialSM(pA0, pA1, m_reg, mnA, alA);
  SLOAD(SO, KVBLK); if (2 < NT) SLOAD(SE, 2 * KVBLK);
  SWAIT(); SWRITE(1, SO); __syncthreads();
  for (int j = 1; j + 1 < NT; j += 2) {
    SBAR(); qkt(pB0, pB1, K_lds + SHM_K, qr, r32, hi);
    finishSM(pA0, pA1, alA, l_reg, pa0, pa1, pa2, pa3); SBAR();
    SLOAD(SO, (j + 2) * KVBLK); SBAR();
    pv_d0(o, vb0, pa0, pa1, pa2, pa3); partialSM(pB0, pB1, m_reg, mnB, alB);
    __syncthreads(); SWAIT(); SWRITE(0, SE);
    RESC(alB); __syncthreads();
    SBAR(); qkt(pA0, pA1, K_lds, qr, r32, hi);
    finishSM(pB0, pB1, alB, l_reg, pa0, pa1, pa2, pa3); SBAR();
    if (j + 3 < NT) SLOAD(SE, (j + 3) * KVBLK); SBAR();
    pv_d0(o, vb0 + (int)SHM_V, pa0, pa1, pa2, pa3); partialSM(pA0, pA1, m_reg, mnA, alA);
    __syncthreads(); SWAIT(); SWRITE(1, SO);
    RESC(alA); __syncthreads();
  }
  SBAR(); qkt(pB0, pB1, K_lds + SHM_K, qr, r32, hi);
  finishSM(pA0, pA1, alA, l_reg, pa0, pa1, pa2, pa3); SBAR();
  pv_d0(o, vb0, pa0, pa1, pa2, pa3); partialSM(pB0, pB1, m_reg, mnB, alB);
  __syncthreads(); RESC(alB);
  finishSM(pB0, pB1, alB, l_reg, pa0, pa1, pa2, pa3); SBAR();
  pv_d0(o, vb0 + (int)SHM_V, pa0, pa1, pa2, pa3);
  if (hi == 0) li_l[r32] = l_reg; asm volatile("s_waitcnt lgkmcnt(0)" ::: "memory");
  float rli[16];
#pragma unroll
  for (int r = 0; r < 16; ++r) rli[r] = __builtin_amdgcn_rcpf(li_l[crow(r, hi)]);
  bf16_t* Ow = Ob + (long)(wid * QBLK) * LDO;
  { bf16_t* stg = (bf16_t*)(lds + 53248) + wid * 4096;
#pragma unroll
    for (int r = 0; r < 16; ++r) { const int orow = crow(r, hi);
#pragma unroll
      for (int d0 = 0; d0 < 4; ++d0) stg[orow * 128 + d0 * 32 + r32] = (bf16_t)(cvt_pk_bf16(o[d0][r] * rli[r], 0.f) & 0xffffu); }
    asm volatile("s_waitcnt lgkmcnt(0)" ::: "memory");
#pragma unroll
    for (int j = 0; j < 8; ++j) { const int idx = j * 64 + lane, row = idx >> 4, ch = idx & 15;
      *(u32x4*)(Ow + (long)row * LDO + ch * 8) = *(const u32x4*)(stg + row * 128 + ch * 8); } }
  __syncthreads();
#undef SLOAD
#undef SWRITE
#undef SWAIT
#undef RESC
}
#undef SBAR
}

constexpr int SCAN_TB = 32, SCAN_STEP_B = 6 * 64 * 4, SCAN_BUF_B = SCAN_TB * SCAN_STEP_B;
#define DPP_Q1 "quad_perm:[1,0,3,2] row_mask:0xf bank_mask:0xf"
#define DPP_Q2 "quad_perm:[2,3,0,1] row_mask:0xf bank_mask:0xf"
#define DPP_HM "row_half_mirror row_mask:0xf bank_mask:0xf"
#define DPP_RM "row_mirror row_mask:0xf bank_mask:0xf"
__device__ __forceinline__ void allreduce16x4(float& a, float& b, float& c, float& d) {
    asm volatile("s_nop 1\n\t"
        "v_add_f32_dpp %0, %0, %0 " DPP_Q1 "\n\tv_add_f32_dpp %1, %1, %1 " DPP_Q1 "\n\tv_add_f32_dpp %2, %2, %2 " DPP_Q1 "\n\tv_add_f32_dpp %3, %3, %3 " DPP_Q1 "\n\t"
        "v_add_f32_dpp %0, %0, %0 " DPP_Q2 "\n\tv_add_f32_dpp %1, %1, %1 " DPP_Q2 "\n\tv_add_f32_dpp %2, %2, %2 " DPP_Q2 "\n\tv_add_f32_dpp %3, %3, %3 " DPP_Q2 "\n\t"
        "v_add_f32_dpp %0, %0, %0 " DPP_HM "\n\tv_add_f32_dpp %1, %1, %1 " DPP_HM "\n\tv_add_f32_dpp %2, %2, %2 " DPP_HM "\n\tv_add_f32_dpp %3, %3, %3 " DPP_HM "\n\t"
        "v_add_f32_dpp %0, %0, %0 " DPP_RM "\n\tv_add_f32_dpp %1, %1, %1 " DPP_RM "\n\tv_add_f32_dpp %2, %2, %2 " DPP_RM "\n\tv_add_f32_dpp %3, %3, %3 " DPP_RM "\n\t"
        : "+v"(a), "+v"(b), "+v"(c), "+v"(d));
}
__device__ __forceinline__ void allreduce16x2(float& a, float& b) {
    asm volatile("s_nop 1\n\t"
        "v_add_f32_dpp %0, %0, %0 " DPP_Q1 "\n\tv_add_f32_dpp %1, %1, %1 " DPP_Q1 "\n\ts_nop 0\n\t"
        "v_add_f32_dpp %0, %0, %0 " DPP_Q2 "\n\tv_add_f32_dpp %1, %1, %1 " DPP_Q2 "\n\ts_nop 0\n\t"
        "v_add_f32_dpp %0, %0, %0 " DPP_HM "\n\tv_add_f32_dpp %1, %1, %1 " DPP_HM "\n\ts_nop 0\n\t"
        "v_add_f32_dpp %0, %0, %0 " DPP_RM "\n\tv_add_f32_dpp %1, %1, %1 " DPP_RM "\n\t"
        : "+v"(a), "+v"(b));
}
__device__ __forceinline__ void allreduce8x4(float& a, float& b, float& c, float& d) {
    asm volatile("s_nop 1\n\t"
        "v_add_f32_dpp %0, %0, %0 " DPP_Q1 "\n\tv_add_f32_dpp %1, %1, %1 " DPP_Q1 "\n\tv_add_f32_dpp %2, %2, %2 " DPP_Q1 "\n\tv_add_f32_dpp %3, %3, %3 " DPP_Q1 "\n\t"
        "v_add_f32_dpp %0, %0, %0 " DPP_Q2 "\n\tv_add_f32_dpp %1, %1, %1 " DPP_Q2 "\n\tv_add_f32_dpp %2, %2, %2 " DPP_Q2 "\n\tv_add_f32_dpp %3, %3, %3 " DPP_Q2 "\n\t"
        "v_add_f32_dpp %0, %0, %0 " DPP_HM "\n\tv_add_f32_dpp %1, %1, %1 " DPP_HM "\n\tv_add_f32_dpp %2, %2, %2 " DPP_HM "\n\tv_add_f32_dpp %3, %3, %3 " DPP_HM "\n\t"
        : "+v"(a), "+v"(b), "+v"(c), "+v"(d));
}
__device__ __forceinline__ void allreduce8x2(float& a, float& b) {
    asm volatile("s_nop 1\n\t"
        "v_add_f32_dpp %0, %0, %0 " DPP_Q1 "\n\tv_add_f32_dpp %1, %1, %1 " DPP_Q1 "\n\ts_nop 0\n\t"
        "v_add_f32_dpp %0, %0, %0 " DPP_Q2 "\n\tv_add_f32_dpp %1, %1, %1 " DPP_Q2 "\n\ts_nop 0\n\t"
        "v_add_f32_dpp %0, %0, %0 " DPP_HM "\n\tv_add_f32_dpp %1, %1, %1 " DPP_HM "\n\t"
        : "+v"(a), "+v"(b));
}
template <int R>
__device__ __forceinline__ void scan_unit(const Args& a, int b_loc, int head, int dir, int rbase, int S, LAS unsigned char* lds, const int tid) {
    const int ls = tid >> 4, lc = tid & 15;
    unsigned char* ws = a.ws;
    const bf16_t* CV = (const bf16_t*)(ws + WS_CONV); const bf16_t* LO = (const bf16_t*)(ws + WS_LORA);
    float* O = (float*)(ws + (dir ? WS_OB : WS_OF));
    const long rowbase = (long)b_loc * S;
    const f32x4 ka = *(const f32x4*)(a.k_a + head * 64 + 4 * lc);
    const int NB = S / SCAN_TB;
    u32x2 lr, lk, lv, lkk, lu, la, lkn;
#define SC_TOKI(i) (rowbase + (dir ? (S - 1 - (i)) : (i)))
#define SC_LOAD(blk) do { const int i_ = (blk) * SCAN_TB + ls; const long tk_ = SC_TOKI(i_), tn_ = SC_TOKI(i_ + 1 < S ? i_ + 1 : i_); \
        const bf16_t* cv_ = CV + (tk_ * 16 + head) * 256 + 4 * lc; const bf16_t* lo_ = LO + tk_ * 4096 + dir * 1024 + head * 64 + 4 * lc; \
        lr = *(const u32x2*)(cv_); lk = *(const u32x2*)(cv_ + 64); lv = *(const u32x2*)(cv_ + 128); lkk = *(const u32x2*)(cv_ + 192); lu = *(const u32x2*)(lo_); la = *(const u32x2*)(lo_ + 2048); \
        lkn = *(const u32x2*)(CV + (tn_ * 16 + head) * 256 + 192 + 4 * lc); } while (0)
#define SC_WRITE(buf) do { const f32x4 r_ = unp4(lr), k_ = unp4(lk), v_ = unp4(lv), kk_ = unp4(lkk), u_ = unp4(lu), a_ = unp4(la), kn_ = unp4(lkn); \
        LAS f32x4* p_ = (LAS f32x4*)(lds + (buf) * SCAN_BUF_B + ls * SCAN_STEP_B); \
        p_[lc] = u_; p_[16 + lc] = kk_ * a_; p_[32 + lc] = k_ * (1.0f + (a_ - 1.0f) * ka); \
        p_[48 + 2 * lc] = (f32x4){r_[0], -kn_[0], r_[1], -kn_[1]}; p_[48 + 2 * lc + 1] = (f32x4){r_[2], -kn_[2], r_[3], -kn_[3]}; p_[80 + lc] = v_; } while (0)
    const int g = tid >> 3, c = tid & 7;
    const bool worker = tid < 256;
    f32x2 s2[R][4];
    float sa[2] = {0.f, 0.f}, ok[2] = {0.f, 0.f};
#pragma unroll
    for (int j = 0; j < R; ++j)
#pragma unroll
        for (int i = 0; i < 4; ++i) s2[j][i] = (f32x2){0.f, 0.f};
    SC_LOAD(0); SC_WRITE(0); __syncthreads();
    float* Ocol = O + head * 64 + rbase + R * g;
    for (int blk = 0; blk < NB; ++blk) {
        if (blk + 1 < NB) SC_LOAD(blk + 1);
        if (worker) {
            const LAS unsigned char* bp = lds + (blk & 1) * SCAN_BUF_B;
#pragma unroll 2
            for (int st = 0; st < SCAN_TB; ++st) {
                const LAS f32x4* p = (const LAS f32x4*)(bp + st * SCAN_STEP_B);
                const f32x4 u0 = p[2 * c], u1 = p[2 * c + 1], b0 = p[16 + 2 * c], b1 = p[16 + 2 * c + 1], k0 = p[32 + 2 * c], k1 = p[32 + 2 * c + 1];
                const f32x4 rn0 = p[48 + 4 * c], rn1 = p[48 + 4 * c + 1], rn2 = p[48 + 4 * c + 2], rn3 = p[48 + 4 * c + 3];
                float vv[2];
                if (R == 2) { const f32x2 v2 = *(const LAS f32x2*)(bp + st * SCAN_STEP_B + 1280 + (rbase + 2 * g) * 4); vv[0] = v2[0]; vv[1] = v2[1]; }
                else { vv[0] = *(const LAS float*)(bp + st * SCAN_STEP_B + 1280 + (rbase + g) * 4); vv[1] = 0.f; }
                const f32x2 uu[4] = {(f32x2){u0[0], u0[1]}, (f32x2){u0[2], u0[3]}, (f32x2){u1[0], u1[1]}, (f32x2){u1[2], u1[3]}};
                const f32x2 bb[4] = {(f32x2){b0[0], b0[1]}, (f32x2){b0[2], b0[3]}, (f32x2){b1[0], b1[1]}, (f32x2){b1[2], b1[3]}};
                const f32x2 kd[4] = {(f32x2){k0[0], k0[1]}, (f32x2){k0[2], k0[3]}, (f32x2){k1[0], k1[1]}, (f32x2){k1[2], k1[3]}};
                const f32x4 rn[4] = {rn0, rn1, rn2, rn3};
                float o[2] = {0.f, 0.f}, sn[2] = {0.f, 0.f};
#pragma unroll
                for (int j = 0; j < R; ++j) {
                    f32x2 acc = (f32x2){0.f, 0.f};
#pragma unroll
                    for (int i = 0; i < 4; ++i) {
                        f32x2 t = s2[j][i] - s2[j][i] * uu[i]; t = t + sa[j] * bb[i]; t = t + vv[j] * kd[i]; s2[j][i] = t;
                        acc = acc + t[0] * (f32x2){rn[i][0], rn[i][1]}; acc = acc + t[1] * (f32x2){rn[i][2], rn[i][3]};
                    }
                    o[j] = acc[0]; sn[j] = acc[1];
                }
                if (R == 2) allreduce8x4(o[0], o[1], sn[0], sn[1]); else allreduce8x2(o[0], sn[0]);
                sa[0] = sn[0]; sa[1] = sn[1];
                const bool mine = ((st & 7) == c);
                ok[0] = mine ? o[0] : ok[0]; if (R == 2) ok[1] = mine ? o[1] : ok[1];
                if ((st & 7) == 7) {
                    float* op = Ocol + SC_TOKI(blk * SCAN_TB + (st & 24) + c) * 1024;
                    if (R == 2) *(f32x2*)op = (f32x2){ok[0], ok[1]}; else *op = ok[0];
                }
            }
        }
        if (blk + 1 < NB) SC_WRITE((blk + 1) & 1);
        __syncthreads();
    }
#undef SC_TOKI
#undef SC_LOAD
#undef SC_WRITE
}

namespace cs {
constexpr int SA = 64, SB = 32, SV = 16;
constexpr int SAR = 72;
constexpr int O_AR = 0, O_BKT = 4608, O_VT = 8704, O_GM = 10752, O_XT = 12800, O_GC = 13824, SLOT_B = 14080;
constexpr int NPROD = 5;
constexpr int O_PSCR = 2 * NPROD * SLOT_B, PSCR_B = 1024, O_CSCR = O_PSCR + NPROD * PSCR_B, CSCR_B = 0;
static_assert(O_CSCR + 2 * CSCR_B <= LDS_BYTES - 64, "scan LDS map");
__device__ __forceinline__ int crow(int r, int hi) { return (r & 3) + 8 * (r >> 2) + 4 * hi; }
__device__ __forceinline__ bf16_t tobf(float x) { return (bf16_t)(cvt_pk_bf16(x, 0.f) & 0xffffu); }
#define CS_LWAIT() asm volatile("s_waitcnt lgkmcnt(0)" ::: "memory")

struct PRaw { u32x4 c[8]; u32x4 o[4]; };
__device__ __forceinline__ void produce_load(PRaw& R, const Args& a, long rowbase, int head, int dir, int S, int q, int l) {
    const bf16_t* CV = (const bf16_t*)(a.ws + WS_CONV); const bf16_t* LO = (const bf16_t*)(a.ws + WS_LORA);
#pragma unroll
    for (int j = 0; j < 8; ++j) { const int t = 2 * j + (l >> 5), i = 16 * q + t; const long tok = rowbase + (dir ? (S - 1 - i) : i);
        R.c[j] = __builtin_nontemporal_load((const u32x4*)(CV + (tok * 16 + head) * 256 + (l & 31) * 8)); }
#pragma unroll
    for (int j = 0; j < 4; ++j) { const int t = 4 * j + (l >> 4), i = 16 * q + t; const long tok = rowbase + (dir ? (S - 1 - i) : i);
        R.o[j] = __builtin_nontemporal_load((const u32x4*)(LO + tok * 4096 + dir * 1024 + head * 64 + ((l >> 3) & 1) * 2048 + (l & 7) * 8)); }
}
__device__ __forceinline__ void produce_build(const PRaw& R, const Args& a, LAS unsigned char* slot, LAS unsigned char* scr, int head, int l) {
    LAS bf16_t* AR = (LAS bf16_t*)(slot + O_AR); LAS bf16_t* BKt = (LAS bf16_t*)(slot + O_BKT); LAS bf16_t* Vt = (LAS bf16_t*)(slot + O_VT);
    LAS bf16_t* GM = (LAS bf16_t*)(slot + O_GM); LAS bf16_t* XT = (LAS bf16_t*)(slot + O_XT);
    LAS float* GC = (LAS float*)(slot + O_GC); LAS bf16_t* BK = (LAS bf16_t*)(slot + O_VT); LAS float* NM = (LAS float*)scr;
    const float ka = a.k_a[head * 64 + l];
    const int pl = (l & 32) | (((l >> 4) & 1) << 4) | (((l >> 2) & 1) << 3) | (((l >> 3) & 1) << 2) | (l & 3);
    { LAS unsigned char* raw = (LAS unsigned char*)slot;
#pragma unroll
      for (int j = 0; j < 8; ++j) *(LAS u32x4*)(raw + (2 * j + (l >> 5)) * 512 + (l & 31) * 16) = R.c[j];
#pragma unroll
      for (int j = 0; j < 4; ++j) *(LAS u32x4*)(raw + 8192 + (4 * j + (l >> 4)) * 256 + ((l >> 3) & 1) * 128 + (l & 7) * 16) = R.o[j]; }
    CS_LWAIT();
    bf16_t Lr[16], Lk[16], Lv[16], Lkk[16], Lu[16], La[16];
    { const LAS bf16_t* raw = (const LAS bf16_t*)slot;
#pragma unroll
      for (int t = 0; t < 16; ++t) { Lr[t] = raw[t * 256 + l]; Lk[t] = raw[t * 256 + 64 + l]; Lv[t] = raw[t * 256 + 128 + l]; Lkk[t] = raw[t * 256 + 192 + l];
          Lu[t] = raw[4096 + t * 128 + l]; La[t] = raw[4096 + t * 128 + 64 + l]; } }
    CS_LWAIT();
    float g = 1.0f, ig = 1.0f;
    u32x4 pb[2], pk[2], pv[2];
#pragma unroll
    for (int t2 = 0; t2 < 8; ++t2) {
        float ah[2], rh[2], bh[2], kh[2];
#pragma unroll
        for (int e = 0; e < 2; ++e) { const int t = 2 * t2 + e;
            const float r = bf1(Lr[t]), k = bf1(Lk[t]), kk = bf1(Lkk[t]), u = bf1(Lu[t]), aa = bf1(La[t]);
            const float gp = g, w_ = 1.0f - u; g = g * w_; ig = ig * __builtin_amdgcn_rcpf(w_);
            ah[e] = -kk * gp; rh[e] = r * g; bh[e] = kk * aa * ig; kh[e] = k * (1.0f + (aa - 1.0f) * ka) * ig; }
        const unsigned wa = cvt_pk_bf16(ah[0], ah[1]), wr = cvt_pk_bf16(rh[0], rh[1]), wb = cvt_pk_bf16(bh[0], bh[1]), wk = cvt_pk_bf16(kh[0], kh[1]);
        const int t = 2 * t2;
        AR[t * SAR + pl] = (bf16_t)(wa & 0xffffu); AR[(t + 1) * SAR + pl] = (bf16_t)(wa >> 16);
        AR[(16 + t) * SAR + pl] = (bf16_t)(wr & 0xffffu); AR[(17 + t) * SAR + pl] = (bf16_t)(wr >> 16);
        BK[t * SA + pl] = (bf16_t)(wb & 0xffffu); BK[(t + 1) * SA + pl] = (bf16_t)(wb >> 16);
        BK[(16 + t) * SA + pl] = (bf16_t)(wk & 0xffffu); BK[(17 + t) * SA + pl] = (bf16_t)(wk >> 16);
        { constexpr int pp[8] = {0, 1, 4, 5, 2, 3, 6, 7}; pb[pp[t2] >> 2][pp[t2] & 3] = wb; }
        pk[t2 >> 2][t2 & 3] = wk;
        pv[t2 >> 2][t2 & 3] = ((unsigned)Lv[t]) | (((unsigned)Lv[t + 1]) << 16);
    }
    { LAS u32x4* bt = (LAS u32x4*)(BKt + l * SB); bt[0] = pb[0]; bt[1] = pb[1]; bt[2] = pk[0]; bt[3] = pk[1]; }
    GC[l] = g;
    CS_LWAIT();
    const int n = l & 31, hi = l >> 5;
    f32x16 G = {};
#pragma unroll
    for (int ks = 0; ks < 4; ++ks) {
        const bf16x8 fa = *(const LAS bf16x8*)(AR + n * SAR + 16 * ks + 8 * hi), fb = *(const LAS bf16x8*)(BK + n * SA + 16 * ks + 8 * hi);
        G = __builtin_amdgcn_mfma_f32_32x32x16_bf16(fa, fb, G, 0, 0, 0);
    }
    CS_LWAIT();
    { LAS u32x4* vt = (LAS u32x4*)(Vt + l * SV); vt[0] = pv[0]; vt[1] = pv[1]; }
#pragma unroll
    for (int r = 0; r < 16; ++r) {
        const int tp = crow(r, hi); const float val = G[r];
        const int j = n & 15;
        const bool keep = (r < 8) ? ((n >= 16) && (j < tp)) : (j <= tp - 16);
        const int gcol = (n < 16) ? ((((n >> 2) & 1) << 3) | ((n >> 3) << 2) | (n & 3)) : n;
        GM[tp * SB + gcol] = keep ? tobf(val) : (bf16_t)0;
    }
    if (n < 16) {
#pragma unroll
        for (int r = 0; r < 8; ++r) { const int tp = crow(r, hi); NM[tp * 16 + n] = (n < tp) ? G[r] : 0.f; }
    }
    { const int rr = 16 + (l >> 2), cc = (l & 3) * 4; LAS u32x2* z = (LAS u32x2*)(XT + rr * SV + cc); *z = (u32x2){0u, 0u}; }
    CS_LWAIT();
    { const int c = l & 15; float x[16];
#pragma unroll
      for (int t = 0; t < 16; ++t) {
          const f32x4 n0 = *(const LAS f32x4*)(NM + t * 16), n1 = *(const LAS f32x4*)(NM + t * 16 + 4), n2 = *(const LAS f32x4*)(NM + t * 16 + 8), n3 = *(const LAS f32x4*)(NM + t * 16 + 12);
          const float nr[16] = {n0[0], n0[1], n0[2], n0[3], n1[0], n1[1], n1[2], n1[3], n2[0], n2[1], n2[2], n2[3], n3[0], n3[1], n3[2], n3[3]};
          float ac[4] = {(t == c) ? 1.0f : 0.0f, 0.f, 0.f, 0.f};
#pragma unroll
          for (int j = 0; j < t; ++j) ac[j & 3] = fmaf(nr[j], x[j], ac[j & 3]);
          x[t] = (ac[0] + ac[1]) + (ac[2] + ac[3]);
      }
      if (l < 16) {
#pragma unroll
          for (int t = 0; t < 16; ++t) XT[t * SV + ((((c >> 2) & 1) << 3) | ((c >> 3) << 2) | (c & 3))] = tobf(x[t]);
      } }
    CS_LWAIT();
}

__device__ __forceinline__ bf16x8 pack_acc8(const f32x16& d, int base) {
    u32x4 w; w.x = cvt_pk_bf16(d[base + 0], d[base + 1]); w.y = cvt_pk_bf16(d[base + 2], d[base + 3]); w.z = cvt_pk_bf16(d[base + 4], d[base + 5]); w.w = cvt_pk_bf16(d[base + 6], d[base + 7]);
    return __builtin_bit_cast(bf16x8, w);
}
__device__ __forceinline__ void consume(const LAS unsigned char* slot, f32x16 (&DS)[2], bf16_t* Obase, long rowoff, int dir, int S, int q, int cw, int l) {
    const LAS bf16_t* AR = (const LAS bf16_t*)(slot + O_AR); const LAS bf16_t* BKt = (const LAS bf16_t*)(slot + O_BKT); const LAS bf16_t* Vt = (const LAS bf16_t*)(slot + O_VT);
    const LAS bf16_t* GM = (const LAS bf16_t*)(slot + O_GM); const LAS bf16_t* XT = (const LAS bf16_t*)(slot + O_XT);
    const LAS float* GC = (const LAS float*)(slot + O_GC);
    const int n = l & 31, hi = l >> 5;
    bf16x8 aA[4], aK0[2], aK1[2]; f32x4 gc[2][4];
#pragma unroll
    for (int i = 0; i < 4; ++i) aA[i] = *(const LAS bf16x8*)(AR + n * SAR + 16 * i + 8 * hi);
    const bf16x8 bV = *(const LAS bf16x8*)(Vt + (32 * cw + n) * SV + 8 * hi);
    const bf16x8 aAK = *(const LAS bf16x8*)(GM + n * SB + 16 + 8 * hi), aARB = *(const LAS bf16x8*)(GM + n * SB + 8 * hi), aX = *(const LAS bf16x8*)(XT + n * SV + 8 * hi);
#pragma unroll
    for (int bm = 0; bm < 2; ++bm) { aK0[bm] = *(const LAS bf16x8*)(BKt + (32 * bm + n) * SB + 8 * hi); aK1[bm] = *(const LAS bf16x8*)(BKt + (32 * bm + n) * SB + 16 + 8 * hi);
#pragma unroll
        for (int g4 = 0; g4 < 4; ++g4) gc[bm][g4] = *(const LAS f32x4*)(GC + 32 * bm + 8 * g4 + 4 * hi); }
    f32x16 D1 = {};
#pragma unroll
    for (int bm = 0; bm < 2; ++bm)
#pragma unroll
        for (int sp = 0; sp < 2; ++sp) D1 = __builtin_amdgcn_mfma_f32_32x32x16_bf16(aA[2 * bm + sp], pack_acc8(DS[bm], 8 * sp), D1, 0, 0, 0);
    D1 = __builtin_amdgcn_mfma_f32_32x32x16_bf16(aAK, bV, D1, 0, 0, 0);
    f32x16 UA = {};
    UA = __builtin_amdgcn_mfma_f32_32x32x16_bf16(aX, pack_acc8(D1, 0), UA, 0, 0, 0);
    const bf16x8 bU = pack_acc8(UA, 0);
    D1 = __builtin_amdgcn_mfma_f32_32x32x16_bf16(aARB, bU, D1, 0, 0, 0);
#pragma unroll
    for (int bm = 0; bm < 2; ++bm) {
        DS[bm] = __builtin_amdgcn_mfma_f32_32x32x16_bf16(aK0[bm], bU, DS[bm], 0, 0, 0);
        DS[bm] = __builtin_amdgcn_mfma_f32_32x32x16_bf16(aK1[bm], bV, DS[bm], 0, 0, 0);
#pragma unroll
        for (int r = 0; r < 16; ++r) DS[bm][r] *= gc[bm][r >> 2][r & 3];
    }
    if (dir) { bf16_t* p0 = Obase + (rowoff + (S - 1 - 16 * q) - 4 * hi) * 1024 + n;
#pragma unroll
        for (int r = 8; r < 16; ++r) p0[-1024 * ((r & 3) + 8 * ((r >> 2) - 2))] = tobf(D1[r]);
    } else { bf16_t* p0 = Obase + (rowoff + 16 * q + 4 * hi) * 1024 + n;
#pragma unroll
        for (int r = 8; r < 16; ++r) p0[1024 * ((r & 3) + 8 * ((r >> 2) - 2))] = tobf(D1[r]);
    }
}

__device__ __forceinline__ void aux_rows(const float* __restrict__ xnext, bf16_t* __restrict__ xn_out, const f32x4 (&gn)[4], float* __restrict__ oprev, const f32x4 (&gf)[4],
                                         int rb, int re, int l) {
    f32x4 vx[3][4], vo[3][4];
#pragma unroll
    for (int i = 0; i < 3; ++i) { const int row = rb + i;
        if (row < re) {
            if (xnext) {
#pragma unroll
                for (int j = 0; j < 4; ++j) vx[i][j] = __builtin_nontemporal_load((const f32x4*)(xnext + (size_t)row * DM) + l + 64 * j); }
            if (oprev) {
#pragma unroll
                for (int j = 0; j < 4; ++j) vo[i][j] = __builtin_nontemporal_load((const f32x4*)(oprev + (size_t)row * DM) + l + 64 * j); }
        } }
#pragma unroll
    for (int i = 0; i < 3; ++i) { const int row = rb + i;
        if (row < re) {
            if (xnext) { float sx = 0.f;
#pragma unroll
                for (int j = 0; j < 4; ++j) sx += (vx[i][j].x * vx[i][j].x + vx[i][j].y * vx[i][j].y) + (vx[i][j].z * vx[i][j].z + vx[i][j].w * vx[i][j].w);
                const float rstd = 1.0f / sqrtf(wave_sum(sx) * (1.f / DM) + 1e-6f);
                u32x2* o8 = (u32x2*)(xn_out + (size_t)row * DM) + l;
#pragma unroll
                for (int j = 0; j < 4; ++j) { u32x2 w; w.x = cvt_pk_bf16(vx[i][j].x * rstd * gn[j].x, vx[i][j].y * rstd * gn[j].y); w.y = cvt_pk_bf16(vx[i][j].z * rstd * gn[j].z, vx[i][j].w * rstd * gn[j].w); o8[64 * j] = w; } }
            if (oprev) { float so = 0.f;
#pragma unroll
                for (int j = 0; j < 4; ++j) so += (vo[i][j].x * vo[i][j].x + vo[i][j].y * vo[i][j].y) + (vo[i][j].z * vo[i][j].z + vo[i][j].w * vo[i][j].w);
                const float rstd = 1.0f / sqrtf(wave_sum(so) * (1.f / DM) + 1e-6f);
                f32x4* op = (f32x4*)(oprev + (size_t)row * DM) + l;
#pragma unroll
                for (int j = 0; j < 4; ++j) __builtin_nontemporal_store(vo[i][j] * rstd * gf[j], op + 64 * j); }
        } }
}

__device__ __forceinline__ void scan_unit(const Args& a, int b_loc, int head, int dir, int S, LAS unsigned char* lds, const int tid,
                                          const float* xnext, bf16_t* xn_out, float* oprev, const int arow0, const int arows) {
    const int wv = __builtin_amdgcn_readfirstlane(tid >> 6), l = tid & 63;
    const long rowbase = (long)b_loc * S;
    const int NCH = S / 16, NG = (NCH + NPROD - 1) / NPROD;
    bf16_t* O = (bf16_t*)(a.ws + (dir ? WS_OB : WS_OF));
    f32x16 DS[2] = {};
    const bool prod = (wv >= 2 && wv < 2 + NPROD);
    PRaw R;
    if (prod) { produce_load(R, a, rowbase, head, dir, S, wv - 2, l);
                produce_build(R, a, lds + (wv - 2) * SLOT_B, lds + O_PSCR + (wv - 2) * PSCR_B, head, l);
                produce_load(R, a, rowbase, head, dir, S, NPROD + (wv - 2), l); }
    f32x4 gn[4], gf[4];
    if (wv == 7) {
#pragma unroll
        for (int j = 0; j < 4; ++j) { gn[j] = ((const f32x4*)a.norm_g)[l + 64 * j]; gf[j] = ((const f32x4*)a.final_g)[l + 64 * j]; } }
    __syncthreads();
    for (int g = 0; g < NG; ++g) {
        int l2 = l; asm volatile("" : "+v"(l2));
        if (wv == 7) aux_rows(xnext, xn_out, gn, oprev, gf, arow0 + (g * arows) / NG, arow0 + ((g + 1) * arows) / NG, l2);
        else if (prod) { const int q = NPROD * (g + 1) + (wv - 2);
            if (q < NCH) { produce_build(R, a, lds + (((g + 1) & 1) * NPROD + (wv - 2)) * SLOT_B, lds + O_PSCR + (wv - 2) * PSCR_B, head, l2);
                           if (q + NPROD < NCH) produce_load(R, a, rowbase, head, dir, S, q + NPROD, l2); } }
        else if (wv < 2) {
            for (int c = 0; c < NPROD; ++c) { const int q = NPROD * g + c; int l3 = l2; asm volatile("" : "+v"(l3));
                if (q < NCH) consume(lds + ((g & 1) * NPROD + c) * SLOT_B, DS, O + head * 64 + 32 * wv, rowbase, dir, S, q, wv, l3); }
        }
        __syncthreads();
    }
}
}

__device__ __forceinline__ void phase_post(const Args& a, int gw, int NGW, int lane) {
    unsigned char* ws = a.ws;
    const bf16_t* H = (const bf16_t*)(ws + WS_H); const bf16_t* AT = (const bf16_t*)(ws + WS_ATT);
    const bf16_t* OF = (const bf16_t*)(ws + WS_OF); const bf16_t* OB = (const bf16_t*)(ws + WS_OB);
    const bf16_t* CV = (const bf16_t*)(ws + WS_CONV); const float* BN = (const float*)(ws + WS_BONUS);
    bf16_t* OA = (bf16_t*)(ws + WS_OA); bf16_t* ORG = (bf16_t*)(ws + WS_ORG);
    const float d1 = wave_sum(a.lq1[lane] * a.lk1[lane]), d2 = wave_sum(a.lq2[lane] * a.lk2[lane]);
    const float lam = expf(d1) - expf(d2) + 0.2f;
    const int q = lane >> 4, l16 = lane & 15;
    {
        const f32x4 sg0 = *(const f32x4*)(a.subln_g + 8 * l16) * 0.8f, sg1 = *(const f32x4*)(a.subln_g + 8 * l16 + 4) * 0.8f;
        for (int it0 = gw * 4 + q; it0 < TCH * 8; it0 += NGW * 8) {
            u32x4 ra[2], rb[2], rg[2];
#pragma unroll
            for (int e = 0; e < 2; ++e) { const int it = it0 + e * NGW * 4, t = it >> 3, h = it & 7; if (it >= TCH * 8) continue;
                const bf16_t* p1 = AT + (size_t)t * 2048 + (h * 2) * 128 + 8 * l16;
                ra[e] = __builtin_nontemporal_load((const u32x4*)p1); rb[e] = __builtin_nontemporal_load((const u32x4*)(p1 + 128)); rg[e] = __builtin_nontemporal_load((const u32x4*)(H + (size_t)t * PIN + C_GA + h * 128 + 8 * l16)); }
#pragma unroll
            for (int e = 0; e < 2; ++e) { const int it = it0 + e * NGW * 4, t = it >> 3, h = it & 7; if (it >= TCH * 8) continue;
                float fa[8], fb[8], gt[8]; unpack8(ra[e], fa); unpack8(rb[e], fb); unpack8(rg[e], gt);
                float x[8], ss = 0.f;
#pragma unroll
                for (int i = 0; i < 8; ++i) { x[i] = fa[i] - lam * fb[i]; ss = fmaf(x[i], x[i], ss); }
                ss = allreduce16(ss);
                const float rstd = 1.0f / sqrtf(ss * (1.0f / 128.0f) + 1e-5f);
                float y[8];
#pragma unroll
                for (int i = 0; i < 8; ++i) y[i] = x[i] * rstd * (i < 4 ? sg0[i] : sg1[i - 4]) * gt[i] * fsigmoid(gt[i]);
                *(u32x4*)(OA + (size_t)t * 2048 + h * 128 + 8 * l16) = pack8((f32x4){y[0], y[1], y[2], y[3]}, (f32x4){y[4], y[5], y[6], y[7]}); }
        }
    }
    {
        const int hd = 8 * (gw & 1) + (lane >> 3), hc = hd * 64 + 8 * (lane & 7);
        const f32x4 lg0 = *(const f32x4*)(a.lnx_g + hc), lg1 = *(const f32x4*)(a.lnx_g + hc + 4), lb0 = *(const f32x4*)(a.lnx_b + hc), lb1 = *(const f32x4*)(a.lnx_b + hc + 4);
        for (int t0 = gw >> 1; t0 < TCH; t0 += NGW) {
            u32x4 r_of[2], r_ob[2], r_v[2], r_g[2]; float r_bn[2];
#pragma unroll
            for (int e = 0; e < 2; ++e) { const int t = t0 + e * (NGW >> 1); if (t >= TCH) continue;
                r_of[e] = __builtin_nontemporal_load((const u32x4*)(OF + (size_t)t * DM + hc)); r_ob[e] = __builtin_nontemporal_load((const u32x4*)(OB + (size_t)t * DM + hc));
                r_v[e] = __builtin_nontemporal_load((const u32x4*)(CV + ((size_t)t * 16 + hd) * 256 + 128 + 8 * (lane & 7))); r_g[e] = __builtin_nontemporal_load((const u32x4*)(H + (size_t)t * PIN + C_GR + hc)); r_bn[e] = BN[t * 16 + hd]; }
#pragma unroll
            for (int e = 0; e < 2; ++e) { const int t = t0 + e * (NGW >> 1); if (t >= TCH) continue;
                float of[8], ob[8], vv[8], gr[8], o[8];
                unpack8(r_of[e], of); unpack8(r_ob[e], ob); unpack8(r_v[e], vv); unpack8(r_g[e], gr);
                float sm = 0.f;
#pragma unroll
                for (int i = 0; i < 8; ++i) { o[i] = of[i] + ob[i]; sm += o[i]; }
                sm += dpp_mov<0xB1>(sm); sm += dpp_mov<0x4E>(sm); sm += dpp_mov<0x141>(sm);
                const float mu = sm * (1.0f / 64.0f); float vs = 0.f;
#pragma unroll
                for (int i = 0; i < 8; ++i) { o[i] -= mu; vs = fmaf(o[i], o[i], vs); }
                vs += dpp_mov<0xB1>(vs); vs += dpp_mov<0x4E>(vs); vs += dpp_mov<0x141>(vs);
                const float rs = 1.0f / sqrtf(vs * (1.0f / 64.0f) + 64e-5f), bn = r_bn[e];
                float y[8];
#pragma unroll
                for (int i = 0; i < 8; ++i) { const float lg = i < 4 ? lg0[i] : lg1[i - 4], lb = i < 4 ? lb0[i] : lb1[i - 4];
                    y[i] = (o[i] * rs * lg + lb + bn * vv[i]) * gr[i] * fsigmoid(gr[i]); }
                *(u32x4*)(OA + (size_t)t * 2048 + 1024 + hc) = pack8((f32x4){y[0], y[1], y[2], y[3]}, (f32x4){y[4], y[5], y[6], y[7]}); }
        }
    }
}

#define XB_TMO      128
#define XB_XCNT(j)  (256  + 64 * (j))
#define XB_XSUB(j)  (1280 + 64 * (j))
#define XB_XGEN(j)  (2304 + 64 * (j))
#define XB_TOP      3328
#define XB_TOPGEN   3392
#define XCD_BAR_WORDS 3456
#define XB_SPIN_CAP (1u << 20)
__device__ __forceinline__ unsigned xb_ld(unsigned* p)              { return __hip_atomic_load(p, __ATOMIC_RELAXED, __HIP_MEMORY_SCOPE_AGENT); }
__device__ __forceinline__ unsigned xb_add(unsigned* p, unsigned v) { return __hip_atomic_fetch_add(p, v, __ATOMIC_RELAXED, __HIP_MEMORY_SCOPE_AGENT); }
__device__ __forceinline__ unsigned xb_xcc_id() { return (unsigned)__builtin_amdgcn_s_getreg((3 << 11) | 20) & 0xFu; }
#define XB_SPIN(cond, bar) do { unsigned _sp = 0; while (cond) { __builtin_amdgcn_s_sleep(1); \
    if ((++_sp & 255u) == 0u) { if (xb_ld(&(bar)[XB_TMO])) break; if (_sp > XB_SPIN_CAP) { atomicAdd(&(bar)[XB_TMO], 1u); break; } } } } while (0)
__device__ __forceinline__ void xcd_barrier_complete(unsigned* bar, unsigned x, unsigned G, unsigned& nloc, unsigned& nx) {
    unsigned sum, cnt, mine, sp = 0u;
    for (;;) {
        sum = 0u; cnt = 0u; mine = 0u;
#pragma unroll
        for (unsigned j = 0; j < 16; ++j) { const unsigned c = xb_ld(&bar[XB_XCNT(j)]); sum += c; cnt += (c > 0u) ? 1u : 0u; mine = (j == x) ? c : mine; }
        if (sum == G) break;
        __builtin_amdgcn_s_sleep(1);
        if ((++sp & 255u) == 0u) { if (xb_ld(&bar[XB_TMO])) break; if (sp > XB_SPIN_CAP) { atomicAdd(&bar[XB_TMO], 1u); break; } }
    }
    nloc = mine > 0u ? mine : 1u; nx = cnt > 0u ? cnt : 1u;
}
__device__ __forceinline__ void xcd_barrier(unsigned* bar, volatile LAS unsigned* st, const bool t0, const unsigned G) {
    asm volatile("s_waitcnt vmcnt(0)" ::: "memory");
    __syncthreads();
    if (t0) {
        __builtin_amdgcn_s_waitcnt(0);
        const unsigned x = xb_xcc_id();
        unsigned nloc = st[0], nx = st[1];
        if (nloc == 0u) { xcd_barrier_complete(bar, x, G, nloc, nx); st[0] = nloc; st[1] = nx; }
        const unsigned old = xb_add(&bar[XB_XSUB(x)], 1u);
        const unsigned gen = old / nloc;
        if (old + 1u == (gen + 1u) * nloc) {
            __builtin_amdgcn_fence(__ATOMIC_RELEASE, "agent");
            asm volatile("s_waitcnt vmcnt(0)" ::: "memory");
            const unsigned og = xb_add(&bar[XB_TOP], 1u);
            const unsigned tg = og / nx;
            if (og + 1u == (tg + 1u) * nx) xb_add(&bar[XB_TOPGEN], 1u);
            else XB_SPIN(xb_ld(&bar[XB_TOPGEN]) == tg, bar);
            __builtin_amdgcn_fence(__ATOMIC_ACQUIRE, "agent");
            xb_add(&bar[XB_XGEN(x)], 1u);
            asm volatile("s_waitcnt vmcnt(0)" ::: "memory");
        } else {
            XB_SPIN(xb_ld(&bar[XB_XGEN(x)]) == gen, bar);
            __builtin_amdgcn_fence(__ATOMIC_ACQUIRE, "agent");
            asm volatile("s_waitcnt vmcnt(0)" ::: "memory");
        }
    }
    __syncthreads();
}

constexpr int N_PHASES = 1 + 6 * NCHUNK + 1;
#define GET_TID() int wave = wave0; asm volatile("" : "+s"(wave)); \
        unsigned zz = 0u; asm volatile("" : "+v"(zz)); \
        int tid = wave * 64 + (int)__builtin_amdgcn_mbcnt_hi(~0u, __builtin_amdgcn_mbcnt_lo(~0u, zz)); asm volatile("" : "+v"(tid)); \
        int bid = blockIdx.x; asm volatile("" : "+s"(bid)); int G = G0; asm volatile("" : "+s"(G)); \
        const int lane = tid & 63; const int gw = bid * NWAVES + wave, NGW = G * NWAVES; (void)lane; (void)gw; (void)NGW;
#if defined(__HIP_DEVICE_COMPILE__)
#define LOAD_ARGS() typedef const __attribute__((address_space(4))) Args* CArgsP; \
        CArgsP ap = (CArgsP)__builtin_amdgcn_kernarg_segment_ptr(); \
        asm volatile("" : "+s"(ap)); \
        Args a; \
        a.x_p = ap->x_p; a.x_s = ap->x_s; a.norm_g = ap->norm_g; a.w_in = ap->w_in; a.conv = ap->conv; a.lq1 = ap->lq1; a.lk1 = ap->lk1; a.lq2 = ap->lq2; a.lk2 = ap->lk2; \
        a.subln_g = ap->subln_g; a.wlu = ap->wlu; a.w0 = ap->w0; a.alu = ap->alu; a.a0 = ap->a0; a.k_k = ap->k_k; a.k_a = ap->k_a; a.r_k = ap->r_k; a.lnx_g = ap->lnx_g; a.lnx_b = ap->lnx_b; \
        a.w_oa = ap->w_oa; a.w_or = ap->w_or; a.w_out = ap->w_out; a.final_g = ap->final_g; a.out = ap->out; a.ws = ap->ws; a.ph_lo = 0; a.ph_hi = 0; \
        unsigned char* ws = a.ws; unsigned* ctl = (unsigned*)(ws + WS_CTL); bf16_t* XN = (bf16_t*)(ws + WS_XN); bf16_t* H = (bf16_t*)(ws + WS_H); (void)ctl; (void)XN; (void)H;
#else
#define LOAD_ARGS() Args a = a_in; unsigned char* ws = a.ws; unsigned* ctl = (unsigned*)(ws + WS_CTL); bf16_t* XN = (bf16_t*)(ws + WS_XN); bf16_t* H = (bf16_t*)(ws + WS_H); (void)ctl; (void)XN; (void)H;
#endif
__global__ void __launch_bounds__(NTHR, 2) mega_fwd(Args a_in) {
    extern __shared__ __attribute__((aligned(16))) unsigned char lds_raw[];
    LAS unsigned char* lds = (LAS unsigned char*)lds_raw;
    cg::grid_group grid = cg::this_grid();
    const int G0 = gridDim.x;
    volatile LAS unsigned* misc = (volatile LAS unsigned*)(lds + LDS_BYTES - 64);
#ifndef PH_MASK
#define PH_MASK 0xff
#endif
#define PROBE_DUP 0
    const int ph_lo = a_in.ph_lo, ph_hi = a_in.ph_hi;
    const int wave0 = __builtin_amdgcn_readfirstlane(threadIdx.x >> 6);
    if (threadIdx.x < 8) misc[threadIdx.x + 8] = 0u;
    __syncthreads();
    if (threadIdx.x == 0) (void)xb_add((unsigned*)(a_in.ws + WS_CTL) + 4096 + XB_XCNT(xb_xcc_id()), 1u);
    for (int p = ph_lo; p < ph_hi; ++p) {
        if (p == 0) { if (!(PH_MASK & 1)) continue; LOAD_ARGS(); GET_TID();
            for (int rep = 0; rep < ((PROBE_DUP & 64) ? 3 : 1); ++rep) {
            phase_weights(a, lds, gw, NGW, lane, wave);
            phase_xn(a.x_p, a.norm_g, XN, TCH, gw, NGW, lane); }
        } else if (p == N_PHASES - 1) { if (!(PH_MASK & 128)) continue; LOAD_ARGS(); GET_TID();
            phase_final(a.out + (size_t)(NCHUNK - 1) * TCH * DM, a.final_g, TCH, gw, NGW, lane);
        } else {
            const int ch = (p - 1) / 6, sub = (p - 1) % 6;
            const int S = ch < 4 ? 2048 : 4096, nb = TCH / S;
            const size_t grow = (size_t)ch * TCH;
            if (sub == 0) { if (!(PH_MASK & 2) || ch >= 1) continue; LOAD_ARGS(); GET_TID();
                {
                pg8::Gemm g{XN, (const bf16_t*)(ws + WS_WIN), TCH, PIN, DM, DM, DM}; pg8::StaticOrder So; So.init(TCH, PIN, G, bid, (PROBE_DUP & 1) ? 2 : 1);
                EpiIn E{H, (bf16_t*)(ws + WS_LW), (const f32x4*)(ws + WS_ROPE), S - 1}; pg8::gemm_phase<DM, DM>(lds, g, So, E, tid); }
            } else if (sub == 1) { if (!(PH_MASK & 4)) continue; LOAD_ARGS(); GET_TID();
#ifndef NO_PREP
                phase_prep(a, S, gw, NGW, lane, false);
#endif
                { if (PROBE_DUP & 2) phase_prep(a, S, gw, NGW, lane, false);
                pg8::Gemm g{(const bf16_t*)(ws + WS_LW), (const bf16_t*)(ws + WS_WLORA), TCH, 4096, 256, 256, 256}; pg8::StaticOrder So; So.init(TCH, 4096, G, bid, (PROBE_DUP & 4) ? 2 : 1);
                EpiLora E{(bf16_t*)(ws + WS_LORA), a.w0, a.a0}; pg8::gemm_phase<256, 256>(lds, g, So, E, tid); }
            } else if (sub == 2) { if (!(PH_MASK & 8)) continue; LOAD_ARGS(); GET_TID();
                const int nscan = nb * 32, nqb = S / 256, natt = nb * 16 * nqb;
                const size_t gnx = grow + TCH;
                const float* xnext = (ch + 1 < NCHUNK) ? (ch + 1 < 4 ? a.x_p + gnx * DM : a.x_s + (gnx - NTOK_P) * DM) : (const float*)nullptr;
                float* oprev = (ch >= 1) ? a.out + (grow - TCH) * DM : (float*)nullptr;
#ifndef PROBE_MIX
#define PROBE_MIX 0
#endif
                for (int rep = 0; rep < (PROBE_MIX ? 2 : 1); ++rep)
                for (;;) {
                    if (tid == 0) misc[0] = atomicAdd(ctl + ch + 8 * rep, 1u);
                    __syncthreads(); unsigned u = misc[0]; __syncthreads();
                    if (rep == 1 && PROBE_MIX == 2) u += nscan;
                    if (rep == 1 && PROBE_MIX == 1 && u >= (unsigned)nscan) break;
                    if (u >= (unsigned)(nscan + natt)) break;
                    int tid_u = tid; asm volatile("" : "+v"(tid_u));
                    if (u < (unsigned)nscan) { const int ar = TCH / nscan;
                        cs::scan_unit(a, u >> 5, (u >> 1) & 15, u & 1, S, lds, tid_u, xnext, (bf16_t*)(ws + (((ch + 1) & 1) ? WS_XN1 : WS_XN)), oprev, (int)u * ar, ar); }
                    else { const int v = u - nscan, qb = v % nqb, hm = (v / nqb) & 15, b = v / (nqb * 16);
                        const size_t r0 = (size_t)b * S;
                        att::attn_body(H + (r0 + qb * 256) * PIN + C_Q + hm * 64, H + r0 * PIN + C_K + hm * 64, H + r0 * PIN + C_V + (hm >> 1) * 128,
                                       (bf16_t*)(ws + WS_ATT) + (r0 + qb * 256) * 2048 + hm * 128, S, (char*)lds_raw, tid_u); }
                }
            } else if (sub == 3) { if (!(PH_MASK & 16)) continue; LOAD_ARGS(); GET_TID();
                for (int rep = 0; rep < ((PROBE_DUP & 8) ? 2 : 1); ++rep) phase_post(a, gw, NGW, lane);
            } else if (sub == 4) { if (!(PH_MASK & 32)) continue; LOAD_ARGS(); GET_TID();
                {
                { pg8::Gemm g{(const bf16_t*)(ws + WS_OA), (const bf16_t*)(ws + WS_WOA), TCH, DM, 2048, 2048, 2048}; pg8::StaticOrder So; So.init(TCH, DM, G, bid, (PROBE_DUP & 16) ? 2 : 1);
                  EpiMix E{(bf16_t*)(ws + WS_M), H}; pg8::gemm_phase<2048, 2048>(lds, g, So, E, tid); } }
            } else { if (!(PH_MASK & 64)) continue; LOAD_ARGS(); GET_TID();
                { pg8::Gemm g{(const bf16_t*)(ws + WS_M), (const bf16_t*)(ws + WS_WOUT), TCH, DM, DM, DM, DM}; pg8::StaticOrder So; So.init(TCH, DM, G, bid, (PROBE_DUP & 32) ? 2 : 1);
                  const float* xc = ch < 4 ? a.x_p + grow * DM : a.x_s + (grow - NTOK_P) * DM; EpiOut E{a.out + grow * DM, xc}; pg8::gemm_phase<DM, DM>(lds, g, So, E, tid); }
                if (ch + 1 < NCHUNK) {
                    int tid2 = tid; asm volatile("" : "+v"(tid2));
                    pg8::Gemm g{(const bf16_t*)(ws + (((ch + 1) & 1) ? WS_XN1 : WS_XN)), (const bf16_t*)(ws + WS_WIN), TCH, PIN, DM, DM, DM}; pg8::StaticOrder So; So.init(TCH, PIN, G, bid);
                    EpiIn E{H, (bf16_t*)(ws + WS_LW), (const f32x4*)(ws + WS_ROPE), (ch + 1 < 4 ? 2048 : 4096) - 1}; pg8::gemm_phase<DM, DM>(lds, g, So, E, tid2); }
            }
        }
        if (p + 1 < ph_hi) {
            if (p == 0) grid.sync();
            else { int wv = wave0; asm volatile("" : "+s"(wv)); unsigned z3 = 0u; asm volatile("" : "+v"(z3));
                   const bool t0 = (wv == 0) && (__builtin_amdgcn_mbcnt_hi(~0u, __builtin_amdgcn_mbcnt_lo(~0u, z3)) == 0u);
                   xcd_barrier((unsigned*)(a_in.ws + WS_CTL) + 4096, misc + 8, t0, (unsigned)G0); }
        }
    }
}

extern "C" void kernel_launch(void* const* d_in, const int* in_sizes, int n_in, void* d_out, int out_size, void* d_ws, size_t ws_size, hipStream_t stream) {
    static int grid = 0;
    if (grid == 0) {
        if (n_in != 23 || ws_size < WS_END) { fprintf(stderr, "kernel_launch: unexpected n_in %d / ws %zu\n", n_in, ws_size); grid = -1; return; }
        int dev = 0, cus = 0, per_cu = 0;
        hipGetDevice(&dev); hipDeviceGetAttribute(&cus, hipDeviceAttributeMultiprocessorCount, dev);
        hipFuncSetAttribute((const void*)mega_fwd, hipFuncAttributeMaxDynamicSharedMemorySize, LDS_BYTES);
        hipOccupancyMaxActiveBlocksPerMultiprocessor(&per_cu, (const void*)mega_fwd, NTHR, LDS_BYTES);
        if (per_cu < 1) { fprintf(stderr, "kernel_launch: occupancy query says %d\n", per_cu); per_cu = 1; }
        grid = cus * 1;
    }
    if (grid < 0) return;
    if (hipMemsetAsync((char*)d_ws + WS_CTL, 0, 65536, stream) != hipSuccess) { fprintf(stderr, "kernel_launch: memset failed\n"); return; }
    Args a{};
    const float** f = (const float**)&a;
    for (int i = 0; i < 23; ++i) f[i] = (const float*)d_in[i];
    a.out = (float*)d_out; a.ws = (unsigned char*)d_ws; a.ph_lo = 0; a.ph_hi = N_PHASES;
    void* args[] = {&a};
    hipError_t e = hipLaunchCooperativeKernel((const void*)mega_fwd, dim3(grid), dim3(NTHR), args, LDS_BYTES, stream);
    if (e != hipSuccess) fprintf(stderr, "cooperative launch failed: %s (grid %d)\n", hipGetErrorString(e), grid);
}
```

```cpp
#include <hip/hip_runtime.h>
#include <hip/hip_bf16.h>
#include <hip/hip_cooperative_groups.h>
#include <cstdio>
#include <cstdint>
namespace cg = cooperative_groups;

constexpr int DM = 1024, PIN = 10496, TCH = 16384, NCHUNK = 6;
constexpr int NTOK_P = 32 * 2048, NTOK_S = 8 * 4096, NTOK = NTOK_P + NTOK_S;
constexpr int C_Q = 0, C_K = 1024, C_V = 2048, C_GA = 3072, C_RKV = 4096, C_GR = 7168, C_WL = 8192, C_GMA = 8448, C_GMB = 9472;
constexpr size_t MiB = 1u << 20;
constexpr size_t WS_CTL = 0;
constexpr size_t WS_WIN = 1 * MiB;
constexpr size_t WS_WOA = 22 * MiB, WS_WOR = 24 * MiB, WS_WOUT = 26 * MiB, WS_WLORA = 28 * MiB;
constexpr size_t WS_ROPE = 30 * MiB;
constexpr size_t WS_BONUS = 31 * MiB;
constexpr size_t WS_XN = 32 * MiB;
constexpr size_t WS_H = 64 * MiB;
constexpr size_t WS_CONV = 392 * MiB;
constexpr size_t WS_LORA = 520 * MiB;
constexpr size_t WS_ATT = 648 * MiB;
constexpr size_t WS_OF = 776 * MiB, WS_OB = 840 * MiB;
constexpr size_t WS_OA = 904 * MiB, WS_ORG = 936 * MiB;
constexpr size_t WS_M = 968 * MiB;
constexpr size_t WS_LW = 1000 * MiB;
constexpr size_t WS_XN1 = 808 * MiB;
constexpr size_t WS_END = 1008 * MiB;

#define LAS __attribute__((address_space(3)))
typedef unsigned short bf16_t;
typedef short bf16x8 __attribute__((ext_vector_type(8)));
typedef short s16x4 __attribute__((ext_vector_type(4)));
typedef float f32x4 __attribute__((ext_vector_type(4)));
typedef float f32x2 __attribute__((ext_vector_type(2)));
typedef float f32x8 __attribute__((ext_vector_type(8)));
typedef float f32x16 __attribute__((ext_vector_type(16)));
typedef unsigned u32x4 __attribute__((ext_vector_type(4)));
typedef unsigned u32x2 __attribute__((ext_vector_type(2)));

typedef __bf16 bf16x2_t __attribute__((ext_vector_type(2)));
__device__ __forceinline__ unsigned cvt_pk_bf16(float lo, float hi) { f32x2 v = {lo, hi}; bf16x2_t b = __builtin_convertvector(v, bf16x2_t); return __builtin_bit_cast(unsigned, b); }
__device__ __forceinline__ float bf_lo(unsigned w) { return __uint_as_float(w << 16); }
__device__ __forceinline__ float bf_hi(unsigned w) { return __uint_as_float(w & 0xffff0000u); }
__device__ __forceinline__ float bf1(bf16_t h) { return __uint_as_float(((unsigned)h) << 16); }
__device__ __forceinline__ float fsigmoid(float x) { return __builtin_amdgcn_rcpf(1.0f + __builtin_amdgcn_exp2f(-1.4426950408889634f * x)); }
__device__ __forceinline__ float ftanh(float x) { float t = __builtin_amdgcn_exp2f(2.8853900817779268f * x); return 1.0f - 2.0f * __builtin_amdgcn_rcpf(t + 1.0f); }
template <int CTRL> __device__ __forceinline__ float dpp_mov(float v) { return __builtin_bit_cast(float, __builtin_amdgcn_update_dpp(0, __builtin_bit_cast(int, v), CTRL, 0xf, 0xf, true)); }
__device__ __forceinline__ float allreduce16(float v) { v += dpp_mov<0xB1>(v); v += dpp_mov<0x4E>(v); v += dpp_mov<0x141>(v); v += dpp_mov<0x140>(v); return v; }
__device__ __forceinline__ float wave_sum(float v) {
    v = allreduce16(v);
    const int iv = __builtin_bit_cast(int, v);
    const float a = __builtin_bit_cast(float, __builtin_amdgcn_readlane(iv, 0)), b = __builtin_bit_cast(float, __builtin_amdgcn_readlane(iv, 16));
    const float c = __builtin_bit_cast(float, __builtin_amdgcn_readlane(iv, 32)), d = __builtin_bit_cast(float, __builtin_amdgcn_readlane(iv, 48));
    return (a + b) + (c + d);
}

namespace pg8 {
constexpr int BM = 256, BK = 64, HALF = 128, HTB = HALF * BK * 2, STAGE_BYTES = 8 * HTB, NXCD = 8, WGM = 4;
__host__ __device__ __forceinline__ int lds_byte(int r, int c) { const int st = (r >> 4) * 2 + (c >> 5), rr = r & 15, cc = c & 31, ob = rr * 64 + cc * 2; return st * 1024 + (ob ^ (((ob >> 9) & 1) << 5)); }
__host__ __device__ __forceinline__ void stage_rc(int b, int& R, int& C) { const int st = b / 1024, sb = b % 1024, swz = sb ^ (((sb >> 9) & 1) << 5); R = (st >> 1) * 16 + swz / 64; C = (st & 1) * 32 + (swz % 64) / 2; }
__host__ __device__ __forceinline__ int perm32(int rho) { const int n = rho >> 4, i = rho & 15; return 8 * (i >> 2) + 4 * n + (i & 3); }
struct Unit { int pm, pn; };
struct Gemm { const bf16_t* A; const bf16_t* Bt; int M, N, K, lda, ldb; };
struct StaticOrder {
    int nM, nN, nwg, G, c, reps;
    __device__ void init(int M, int N, int G_, int c_, int reps_ = 1) { nM = M / BM; nN = N / BM; nwg = nM * nN; G = G_; c = c_; reps = reps_; }
    __device__ bool next(int i, Unit& u) const {
        const long L = (long)i * G + c; if (L >= (long)nwg * reps) return false;
        int wgid = (int)(L % nwg); { const int q = nwg / NXCD, r = nwg % NXCD, xcd = wgid % NXCD, off = wgid / NXCD; wgid = (xcd < r ? xcd * (q + 1) : r * (q + 1) + (xcd - r) * q) + off; }
        const int nig = WGM * nN, gid = wgid / nig, fm = gid * WGM, gsz = (nM - fm) < WGM ? (nM - fm) : WGM;
        u.pm = fm + ((wgid % nig) % gsz); u.pn = (wgid % nig) / gsz; return true;
    }
};
template <class F> __device__ __forceinline__ void epi_foreach(const f32x4 (&acc)[2][2][4][2], const Unit& u, int wr, int wc, int fr, int fq, const F& f) {
    const int row0 = u.pm * BM + wr * 64 + fr, col0 = u.pn * BM + wc * 32 + 8 * fq;
#pragma unroll
    for (int ai = 0; ai < 2; ++ai)
#pragma unroll
        for (int m = 0; m < 4; ++m)
#pragma unroll
            for (int bj = 0; bj < 2; ++bj) { f(row0 + ai * HALF + m * 16, col0 + bj * HALF, acc[ai][bj][m][0], acc[ai][bj][m][1]); if ((m & 1) && bj) asm volatile("" ::: "memory"); }
}

template <class F> __device__ __forceinline__ void acc_foreach(f32x4 (&acc)[2][2][4][2], const Unit& u, int wr, int wc, int fr, int fq, const F& f) {
    const int row0 = u.pm * BM + wr * 64 + fr, col0 = u.pn * BM + wc * 32 + 8 * fq;
#pragma unroll
    for (int ai = 0; ai < 2; ++ai)
#pragma unroll
        for (int m = 0; m < 4; ++m)
#pragma unroll
            for (int bj = 0; bj < 2; ++bj) { f(row0 + ai * HALF + m * 16, col0 + bj * HALF, acc[ai][bj][m][0], acc[ai][bj][m][1]); if ((m & 1) && bj) asm volatile("" ::: "memory"); }
}
template <int LDA, int LDB, class Epi>
__device__ __forceinline__ void gemm_phase(LAS unsigned char* lds, const Gemm g, const StaticOrder& S, const Epi& E, const int tid) {
    const int wid = __builtin_amdgcn_readfirstlane(tid >> 6), lane = tid & 63, wr = wid >> 2, wc = wid & 3, fr = lane & 15, fq = lane >> 4;
    const int K = g.K, nt = K / BK;
    unsigned vofA[2], vofB[2];
    { int R, C; stage_rc(tid * 16, R, C); const int Rb = (R & ~31) + perm32(R & 31);
      vofA[0] = (unsigned)(R * LDA + C) * 2u; vofB[0] = (unsigned)(Rb * LDB + C) * 2u; vofA[1] = vofA[0] + 64u * LDA * 2u; vofB[1] = vofB[0] + 64u * LDB * 2u; }
    constexpr size_t kstep = (size_t)(BK * 2);
    constexpr size_t hstepA = (size_t)HALF * LDA * 2, hstepB = (size_t)HALF * LDB * 2;
    constexpr size_t tstepA = 2 * hstepA, tstepB = 2 * hstepB;
    const unsigned ldsw = (unsigned)wid * 1024u;
#define PG8_SA(b, h) (((b) * 2 + (h)) * HTB)
#define PG8_SB(b, h) ((4 + (b) * 2 + (h)) * HTB)
#define PG8_STAGE(bufoff, gbase, voff) do { _Pragma("unroll") for (int _i = 0; _i < 2; ++_i) \
        __builtin_amdgcn_global_load_lds((const unsigned*)((const char*)(gbase) + vof##voff[_i]), (LAS unsigned*)(lds + (bufoff) + ldsw + _i * 8192), 16, 0, 0); } while (0)
#define PG8_LDA(dst, b, h) do { _Pragma("unroll") for (int m = 0; m < 4; ++m) _Pragma("unroll") for (int k = 0; k < 2; ++k) dst[m][k] = *(const LAS bf16x8*)(lds + PG8_SA(b, h) + aoff + m * 2048 + k * 1024); } while (0)
#define PG8_LDB(dst, b, h) do { _Pragma("unroll") for (int n = 0; n < 2; ++n) _Pragma("unroll") for (int k = 0; k < 2; ++k) dst[n][k] = *(const LAS bf16x8*)(lds + PG8_SB(b, h) + boff + n * 2048 + k * 1024); } while (0)
#define PG8_MMA(ai, bj, At, Bt) do { __builtin_amdgcn_s_setprio(1); _Pragma("unroll") for (int m = 0; m < 4; ++m) _Pragma("unroll") for (int n = 0; n < 2; ++n) _Pragma("unroll") for (int k = 0; k < 2; ++k) \
        acc[ai][bj][m][n] = __builtin_amdgcn_mfma_f32_16x16x32_bf16(Bt[n][k], At[m][k], acc[ai][bj][m][n], 0, 0, 0); __builtin_amdgcn_s_setprio(0); } while (0)
#define PG8_WAIT_V(n) asm volatile("s_waitcnt vmcnt(" #n ")" ::: "memory")
#define PG8_WAIT_L(n) asm volatile("s_waitcnt lgkmcnt(" #n ")" ::: "memory")
#define PG8_BAR __builtin_amdgcn_s_barrier()
#define PG8_SCHED __builtin_amdgcn_sched_barrier(0)
    Unit cur, nxt; int ui = 0;
    if (!S.next(0, cur)) return;
    f32x4 acc[2][2][4][2];
#pragma unroll
    for (int a = 0; a < 2; ++a)
#pragma unroll
        for (int b = 0; b < 2; ++b)
#pragma unroll
            for (int m = 0; m < 4; ++m)
#pragma unroll
                for (int n = 0; n < 2; ++n) acc[a][b][m][n] = (f32x4){0.f, 0.f, 0.f, 0.f};
    bf16x8 At[4][2], B0[2][2], B1[2][2];
    const char* cA = (const char*)g.A + (size_t)cur.pm * tstepA; const char* cB = (const char*)g.Bt + (size_t)cur.pn * tstepB;
#define PG8_LAUNDER asm volatile("" : "+v"(vofA[0]), "+v"(vofA[1]), "+v"(vofB[0]), "+v"(vofB[1]))
    PG8_LAUNDER; PG8_STAGE(PG8_SB(0, 0), cB, B); PG8_LAUNDER; PG8_STAGE(PG8_SB(0, 1), cB + hstepB, B); PG8_LAUNDER; PG8_STAGE(PG8_SA(0, 0), cA, A); PG8_LAUNDER; PG8_STAGE(PG8_SA(0, 1), cA + hstepA, A);
    if (wr == 1) PG8_BAR;
    PG8_WAIT_V(2); PG8_BAR;
    PG8_LAUNDER; PG8_STAGE(PG8_SB(1, 0), cB + kstep, B); PG8_LAUNDER; PG8_STAGE(PG8_SA(1, 0), cA + kstep, A); PG8_LAUNDER; PG8_STAGE(PG8_SB(1, 1), cB + hstepB + kstep, B);
    PG8_WAIT_V(6); PG8_BAR; PG8_LAUNDER;
    for (;;) {
        unsigned zq_ = 0u; asm volatile("" : "+v"(zq_)); const int lq_ = (int)__builtin_amdgcn_mbcnt_hi(~0u, __builtin_amdgcn_mbcnt_lo(~0u, zq_));
        const int aoff = lds_byte(wr * 64 + (lq_ & 15), (lq_ >> 4) * 8), boff = lds_byte(wc * 32 + (lq_ & 15), (lq_ >> 4) * 8);
        const bool has_next = S.next(ui + 1, nxt);
        const char* nA = has_next ? (const char*)g.A + (size_t)nxt.pm * tstepA : cA; const char* nB = has_next ? (const char*)g.Bt + (size_t)nxt.pn * tstepB : cB;
        for (int half = 0; half < (Epi::HAS_MID ? 2 : 1); ++half) {
        if constexpr (Epi::HAS_MID) if (half == 1) { unsigned zm_ = 0u; asm volatile("" : "+v"(zm_)); const int lm_ = (int)__builtin_amdgcn_mbcnt_hi(~0u, __builtin_amdgcn_mbcnt_lo(~0u, zm_)); E.mid(acc, cur, wr, wc, lm_ & 15, lm_ >> 4); }
        const int t_lo = Epi::HAS_MID ? half * (nt / 2) : 0, t_hi = Epi::HAS_MID ? (half + 1) * (nt / 2) : nt;
        for (int t = t_lo; t < t_hi; t += 2) {
            const bool last = (t == nt - 2);
            const char* a1 = cA + (size_t)(t + 1) * kstep;
            const char* a2 = last ? nA : cA + (size_t)(t + 2) * kstep; const char* b2 = last ? nB : cB + (size_t)(t + 2) * kstep;
            const char* a3 = a2 + kstep; const char* b3 = b2 + kstep;
            PG8_LDB(B0, 0, 0); PG8_LDB(B1, 0, 1); PG8_SCHED; PG8_LDA(At, 0, 0); PG8_STAGE(PG8_SA(1, 1), a1 + hstepA, A);
            PG8_WAIT_V(8); PG8_WAIT_L(0); PG8_BAR; PG8_MMA(0, 0, At, B0); PG8_MMA(0, 1, At, B1); PG8_BAR; PG8_SCHED;
            PG8_LDA(At, 0, 1); PG8_STAGE(PG8_SB(0, 0), b2, B); PG8_STAGE(PG8_SB(0, 1), b2 + hstepB, B); PG8_STAGE(PG8_SA(0, 0), a2, A);
            PG8_WAIT_V(8); PG8_WAIT_L(0); PG8_BAR; PG8_MMA(1, 0, At, B0); PG8_MMA(1, 1, At, B1); PG8_BAR; PG8_SCHED;
            PG8_LDB(B0, 1, 0); PG8_LDB(B1, 1, 1); PG8_SCHED; PG8_LDA(At, 1, 0); PG8_STAGE(PG8_SA(0, 1), a2 + hstepA, A);
            PG8_WAIT_V(8); PG8_WAIT_L(0); PG8_BAR; PG8_MMA(0, 0, At, B0); PG8_MMA(0, 1, At, B1); PG8_BAR; PG8_SCHED;
            PG8_LDA(At, 1, 1); PG8_STAGE(PG8_SB(1, 0), b3, B); PG8_STAGE(PG8_SB(1, 1), b3 + hstepB, B); PG8_STAGE(PG8_SA(1, 0), a3, A);
            PG8_WAIT_V(8); PG8_WAIT_L(0); PG8_BAR; PG8_MMA(1, 0, At, B0); PG8_MMA(1, 1, At, B1); PG8_BAR; PG8_SCHED;
        }
        }
        if (wr == 0) PG8_BAR;
        { unsigned z_ = 0u; asm volatile("" : "+v"(z_)); const int ln_ = (int)__builtin_amdgcn_mbcnt_hi(~0u, __builtin_amdgcn_mbcnt_lo(~0u, z_)); E(acc, cur, wr, wc, ln_ & 15, ln_ >> 4); }
        if (!has_next) break;
#pragma unroll
        for (int a = 0; a < 2; ++a)
#pragma unroll
            for (int b = 0; b < 2; ++b)
#pragma unroll
                for (int m = 0; m < 4; ++m)
#pragma unroll
                    for (int n = 0; n < 2; ++n) acc[a][b][m][n] = (f32x4){0.f, 0.f, 0.f, 0.f};
        cur = nxt; cA = nA; cB = nB; ++ui;
        if (wr == 1) PG8_BAR;
    }
    PG8_WAIT_V(0);
    PG8_BAR;
#undef PG8_SA
#undef PG8_SB
#undef PG8_STAGE
#undef PG8_LDA
#undef PG8_LDB
#undef PG8_MMA
#undef PG8_WAIT_V
#undef PG8_WAIT_L
#undef PG8_BAR
#undef PG8_SCHED
}
}

__device__ __forceinline__ u32x4 pack8(f32x4 v0, f32x4 v1) { u32x4 w; w.x = cvt_pk_bf16(v0[0], v0[1]); w.y = cvt_pk_bf16(v0[2], v0[3]); w.z = cvt_pk_bf16(v1[0], v1[1]); w.w = cvt_pk_bf16(v1[2], v1[3]); return w; }
__device__ __forceinline__ void unpack8(u32x4 w, float* f) { f[0] = bf_lo(w.x); f[1] = bf_hi(w.x); f[2] = bf_lo(w.y); f[3] = bf_hi(w.y); f[4] = bf_lo(w.z); f[5] = bf_hi(w.z); f[6] = bf_lo(w.w); f[7] = bf_hi(w.w); }

struct EpiIn {
    static constexpr bool HAS_MID = false;
    bf16_t* H; bf16_t* LW; const f32x4* RT; int smask;
    __device__ __forceinline__ void operator()(const f32x4 (&acc)[2][2][4][2], const pg8::Unit& u, int wr, int wc, int fr, int fq) const {
        const bool lt = (u.pn == C_WL / 256), qk = (u.pn < 8);
        bf16_t* base = lt ? LW - C_WL : H; const size_t pitch = lt ? 256 : PIN;
        const f32x4* rt = RT; const int sm = smask;
        pg8::epi_foreach(acc, u, wr, wc, fr, fq, [&](int row, int col, f32x4 v0, f32x4 v1) {
            if (lt && col < C_WL + 128) {
#pragma unroll
                for (int i = 0; i < 4; ++i) { v0[i] = ftanh(v0[i]); v1[i] = ftanh(v1[i]); }
            }
            if (qk && (col & 63) < 16) {
                const f32x4 c0 = rt[(row & sm) * 4 + ((col >> 3) & 1) * 2], c1 = rt[(row & sm) * 4 + ((col >> 3) & 1) * 2 + 1];
                const f32x4 x1 = v0, x2 = v1;
                v0 = (f32x4){x1[0] * c0[0] - x2[0] * c0[1], x1[1] * c0[2] - x2[1] * c0[3], x1[2] * c1[0] - x2[2] * c1[1], x1[3] * c1[2] - x2[3] * c1[3]};
                v1 = (f32x4){x2[0] * c0[0] + x1[0] * c0[1], x2[1] * c0[2] + x1[1] * c0[3], x2[2] * c1[0] + x1[2] * c1[1], x2[3] * c1[2] + x1[3] * c1[3]};
            }
            *(u32x4*)(base + (size_t)row * pitch + col) = pack8(v0, v1); });
    }
};
struct EpiLora {
    static constexpr bool HAS_MID = false;
    bf16_t* O; const float* w0; const float* a0;
    __device__ __forceinline__ void operator()(const f32x4 (&acc)[2][2][4][2], const pg8::Unit& u, int wr, int wc, int fr, int fq) const {
        bf16_t* Oo = O; const bool isw = (u.pn < 8); const float* bias = isw ? w0 : a0;
        pg8::epi_foreach(acc, u, wr, wc, fr, fq, [&](int row, int col, f32x4 v0, f32x4 v1) {
            const int bc = col & 2047;
            const f32x4 b0 = *(const f32x4*)(bias + bc), b1 = *(const f32x4*)(bias + bc + 4);
#pragma unroll
            for (int i = 0; i < 4; ++i) {
                float z0 = v0[i] + b0[i], z1 = v1[i] + b1[i];
                if (isw) { const float e0 = 0.6065306597126334f * fsigmoid(z0), e1 = 0.6065306597126334f * fsigmoid(z1);
                    v0[i] = 1.0f - __builtin_amdgcn_exp2f(-1.4426950408889634f * e0); v1[i] = 1.0f - __builtin_amdgcn_exp2f(-1.4426950408889634f * e1); }
                else { v0[i] = fsigmoid(z0); v1[i] = fsigmoid(z1); }
            }
            *(u32x4*)(Oo + (size_t)row * 4096 + col) = pack8(v0, v1); });
    }
};
struct EpiMa {
    static constexpr bool HAS_MID = false;
    float* MA; const bf16_t* H; int gcol;
    __device__ __forceinline__ void operator()(const f32x4 (&acc)[2][2][4][2], const pg8::Unit& u, int wr, int wc, int fr, int fq) const {
        float* Mm = MA; const bf16_t* Hh = H; const int gc = gcol;
        pg8::epi_foreach(acc, u, wr, wc, fr, fq, [&](int row, int col, f32x4 v0, f32x4 v1) {
            float gt[8]; unpack8(*(const u32x4*)(Hh + (size_t)row * PIN + gc + col), gt);
#pragma unroll
            for (int i = 0; i < 4; ++i) { v0[i] *= fsigmoid(gt[i]); v1[i] *= fsigmoid(gt[4 + i]); }
            float* p = Mm + (size_t)row * DM + col; *(f32x4*)p = v0; *(f32x4*)(p + 4) = v1; });
    }
};
struct EpiM {
    static constexpr bool HAS_MID = false;
    bf16_t* M; const float* MA; const bf16_t* H; int gcol;
    __device__ __forceinline__ void operator()(const f32x4 (&acc)[2][2][4][2], const pg8::Unit& u, int wr, int wc, int fr, int fq) const {
        bf16_t* Mo = M; const float* Mm = MA; const bf16_t* Hh = H; const int gc = gcol;
        pg8::epi_foreach(acc, u, wr, wc, fr, fq, [&](int row, int col, f32x4 v0, f32x4 v1) {
            float gt[8]; unpack8(*(const u32x4*)(Hh + (size_t)row * PIN + gc + col), gt);
            const float* p = Mm + (size_t)row * DM + col; const f32x4 m0 = *(const f32x4*)p, m1 = *(const f32x4*)(p + 4);
#pragma unroll
            for (int i = 0; i < 4; ++i) { v0[i] = m0[i] + v0[i] * fsigmoid(gt[i]); v1[i] = m1[i] + v1[i] * fsigmoid(gt[4 + i]); }
            *(u32x4*)(Mo + (size_t)row * DM + col) = pack8(v0, v1); });
    }
};
struct EpiMix {
    static constexpr bool HAS_MID = true;
    bf16_t* M; const bf16_t* H;
    __device__ __forceinline__ void mid(f32x4 (&acc)[2][2][4][2], const pg8::Unit& u, int wr, int wc, int fr, int fq) const {
        const bf16_t* Hh = H;
        pg8::acc_foreach(acc, u, wr, wc, fr, fq, [&](int row, int col, f32x4& v0, f32x4& v1) {
            float ga[8], gb[8]; unpack8(*(const u32x4*)(Hh + (size_t)row * PIN + C_GMA + col), ga); unpack8(*(const u32x4*)(Hh + (size_t)row * PIN + C_GMB + col), gb);
#pragma unroll
            for (int i = 0; i < 4; ++i) {
                v0[i] *= (1.0f + __builtin_amdgcn_exp2f(-1.4426950408889634f * gb[i])) * __builtin_amdgcn_rcpf(1.0f + __builtin_amdgcn_exp2f(-1.4426950408889634f * ga[i]));
                v1[i] *= (1.0f + __builtin_amdgcn_exp2f(-1.4426950408889634f * gb[4 + i])) * __builtin_amdgcn_rcpf(1.0f + __builtin_amdgcn_exp2f(-1.4426950408889634f * ga[4 + i])); } });
    }
    __device__ __forceinline__ void operator()(const f32x4 (&acc)[2][2][4][2], const pg8::Unit& u, int wr, int wc, int fr, int fq) const {
        bf16_t* Mo = M; const bf16_t* Hh = H;
        pg8::epi_foreach(acc, u, wr, wc, fr, fq, [&](int row, int col, f32x4 v0, f32x4 v1) {
            float gb[8]; unpack8(*(const u32x4*)(Hh + (size_t)row * PIN + C_GMB + col), gb);
#pragma unroll
            for (int i = 0; i < 4; ++i) { v0[i] *= fsigmoid(gb[i]); v1[i] *= fsigmoid(gb[4 + i]); }
            *(u32x4*)(Mo + (size_t)row * DM + col) = pack8(v0, v1); });
    }
};
struct EpiOut {
    static constexpr bool HAS_MID = false;
    float* out; const float* x;
    __device__ __forceinline__ void operator()(const f32x4 (&acc)[2][2][4][2], const pg8::Unit& u, int wr, int wc, int fr, int fq) const {
        float* oo = out; const float* xx = x;
        pg8::epi_foreach(acc, u, wr, wc, fr, fq, [&](int row, int col, f32x4 v0, f32x4 v1) {
            const size_t off = (size_t)row * DM + col;
            const f32x4 x0 = __builtin_nontemporal_load((const f32x4*)(xx + off)), x1 = __builtin_nontemporal_load((const f32x4*)(xx + off + 4));
            *(f32x4*)(oo + off) = v0 + x0; *(f32x4*)(oo + off + 4) = v1 + x1; });
    }
};

struct Args {
    const float* x_p; const float* x_s; const float* norm_g; const float* w_in; const float* conv; const float* lq1; const float* lk1; const float* lq2; const float* lk2;
    const float* subln_g; const float* wlu; const float* w0; const float* alu; const float* a0; const float* k_k; const float* k_a; const float* r_k; const float* lnx_g; const float* lnx_b;
    const float* w_oa; const float* w_or; const float* w_out; const float* final_g;
    float* out; unsigned char* ws; int ph_lo, ph_hi;
};
constexpr int NWAVES = 8, NTHR = 512;
constexpr int LDS_BYTES = 147456;

__device__ __forceinline__ void p0_transpose_item(const float* W, int K, int N, bf16_t* WT, LAS float* scr, int item, int lane, const int ldwt, const int koff, const bool ropeperm = false) {
    const int nblk = N / 32, kb = item / nblk, nb = item % nblk, k0 = 64 * kb, n0 = 32 * nb;
    int nsrc = n0 + (lane & 31);
    if (ropeperm && nsrc < 2048 && (nsrc & 63) < 16) { const int d = nsrc & 15; nsrc = (nsrc & ~15) | ((d & 3) | (((d >> 2) & 1) << 3) | (((d >> 3) & 1) << 2)); }
#pragma unroll 8
    for (int i = 0; i < 32; ++i) { const int kk = 2 * i + (lane >> 5); scr[kk * 33 + (lane & 31)] = W[(size_t)(k0 + kk) * N + nsrc]; }
    asm volatile("s_waitcnt lgkmcnt(0)" ::: "memory");
    const int c = lane & 7;
#pragma unroll
    for (int j = 0; j < 4; ++j) { const int n = (lane >> 3) + 8 * j; const LAS float* s = scr + (8 * c) * 33 + n;
        u32x4 o; o.x = cvt_pk_bf16(s[0 * 33], s[1 * 33]); o.y = cvt_pk_bf16(s[2 * 33], s[3 * 33]); o.z = cvt_pk_bf16(s[4 * 33], s[5 * 33]); o.w = cvt_pk_bf16(s[6 * 33], s[7 * 33]);
        *(u32x4*)(WT + (size_t)(n0 + n) * ldwt + koff + k0 + 8 * c) = o; }
    asm volatile("s_waitcnt lgkmcnt(0)" ::: "memory");
}

__device__ __forceinline__ void phase_weights(const Args& a, LAS unsigned char* lds, int gw, int NGW, int lane, int wave) {
    unsigned char* ws = a.ws;
    LAS float* scr = (LAS float*)(lds + wave * 16384);
    constexpr int I_IN = (DM / 64) * (PIN / 32), I_SQ = (DM / 64) * (DM / 32);
    for (int it = gw; it < I_IN + 3 * I_SQ; it += NGW) {
        int r = it;
        if (r < I_IN) { p0_transpose_item(a.w_in, DM, PIN, (bf16_t*)(ws + WS_WIN), scr, r, lane, DM, 0, true); continue; } r -= I_IN;
        if (r < I_SQ) { p0_transpose_item(a.w_oa, DM, DM, (bf16_t*)(ws + WS_WOA), scr, r, lane, 2048, 0); continue; } r -= I_SQ;
        if (r < I_SQ) { p0_transpose_item(a.w_or, DM, DM, (bf16_t*)(ws + WS_WOA), scr, r, lane, 2048, 1024); continue; } r -= I_SQ;
        p0_transpose_item(a.w_out, DM, DM, (bf16_t*)(ws + WS_WOUT), scr, r, lane, DM, 0);
    }
    bf16_t* WL = (bf16_t*)(ws + WS_WLORA);
    for (int e = gw * 64 + lane; e < 4096 * 256; e += NGW * 64) {
        const int n = e >> 8, k = e & 255, kind = n >> 10, ch = n & 1023, j = k - 64 * kind;
        float v = 0.f;
        if (j >= 0 && j < 64) { const float* src = (kind < 2) ? a.wlu : a.alu; v = src[((size_t)(kind & 1) * 64 + j) * 1024 + ch]; }
        WL[e] = (bf16_t)(cvt_pk_bf16(v, 0.f) & 0xffffu);
    }
    f32x2* RT = (f32x2*)(ws + WS_ROPE);
    for (int e = gw * 64 + lane; e < 4096 * 8; e += NGW * 64) {
        const int pos = e >> 3, i = e & 7;
        const float inv = exp2f(-(float)i * (0.125f * 18.931568569324174f));
        const float ang = (float)pos * inv;
        const float n = rintf(ang * 0.15915494309189535f);
        float r = fmaf(-n, 6.28125f, ang); r = fmaf(-n, 1.9353071795864769e-3f, r);
        RT[e] = (f32x2){__cosf(r), __sinf(r)};
    }
}

__device__ __forceinline__ void phase_xn(const float* x, const float* g, bf16_t* XN, int nrows, int gw, int NGW, int lane) {
    f32x4 gv[4];
#pragma unroll
    for (int j = 0; j < 4; ++j) gv[j] = ((const f32x4*)g)[lane + 64 * j];
    for (int m = gw; m < nrows; m += NGW) {
        const f32x4* xr = (const f32x4*)(x + (size_t)m * DM) + lane;
        f32x4 v[4]; float s = 0.f;
#pragma unroll
        for (int j = 0; j < 4; ++j) { v[j] = __builtin_nontemporal_load(xr + 64 * j); s += (v[j].x * v[j].x + v[j].y * v[j].y) + (v[j].z * v[j].z + v[j].w * v[j].w); }
        const float rstd = 1.0f / sqrtf(wave_sum(s) * (1.f / DM) + 1e-6f);
        u32x2* o8 = (u32x2*)(XN + (size_t)m * DM) + lane;
#pragma unroll
        for (int j = 0; j < 4; ++j) { u32x2 w; w.x = cvt_pk_bf16(v[j].x * rstd * gv[j].x, v[j].y * rstd * gv[j].y); w.y = cvt_pk_bf16(v[j].z * rstd * gv[j].z, v[j].w * rstd * gv[j].w); o8[64 * j] = w; }
    }
}
__device__ __forceinline__ void phase_final(float* out, const float* g, int nrows, int gw, int NGW, int lane) {
    f32x4 gv[4];
#pragma unroll
    for (int j = 0; j < 4; ++j) gv[j] = ((const f32x4*)g)[lane + 64 * j];
    for (int m = gw; m < nrows; m += NGW) {
        f32x4* xr = (f32x4*)(out + (size_t)m * DM) + lane;
        f32x4 v[4]; float s = 0.f;
#pragma unroll
        for (int j = 0; j < 4; ++j) { v[j] = __builtin_nontemporal_load(xr + 64 * j); s += (v[j].x * v[j].x + v[j].y * v[j].y) + (v[j].z * v[j].z + v[j].w * v[j].w); }
        const float rstd = 1.0f / sqrtf(wave_sum(s) * (1.f / DM) + 1e-6f);
#pragma unroll
        for (int j = 0; j < 4; ++j) __builtin_nontemporal_store(v[j] * rstd * gv[j], xr + 64 * j);
    }
}

__device__ __forceinline__ f32x4 unp4(u32x2 w) { return (f32x4){bf_lo(w.x), bf_hi(w.x), bf_lo(w.y), bf_hi(w.y)}; }
__device__ __forceinline__ u32x2 pk4(f32x4 v) { u32x2 w; w.x = cvt_pk_bf16(v[0], v[1]); w.y = cvt_pk_bf16(v[2], v[3]); return w; }
__device__ __forceinline__ void phase_prep(const Args& a, int S, int gw, int NGW, int lane, const bool do_rope) {
    unsigned char* ws = a.ws;
    bf16_t* H = (bf16_t*)(ws + WS_H); bf16_t* CV = (bf16_t*)(ws + WS_CONV); float* BN = (float*)(ws + WS_BONUS);
    const f32x4* RT = (const f32x4*)(ws + WS_ROPE);
    if (do_rope)
    for (int it = gw * 64 + lane; it < TCH * 32; it += NGW * 64) {
        const int t = it >> 5, grp = it & 31, pos = t % S;
        bf16_t* p = H + (size_t)t * PIN + grp * 64;
        const u32x4 w1 = *(const u32x4*)p, w2 = *(const u32x4*)(p + 8);
        float x1[8], x2[8], y1[8], y2[8]; unpack8(w1, x1); unpack8(w2, x2);
#pragma unroll
        for (int j = 0; j < 4; ++j) { const f32x4 cs = RT[pos * 4 + j];
            y1[2 * j] = x1[2 * j] * cs[0] - x2[2 * j] * cs[1]; y2[2 * j] = x2[2 * j] * cs[0] + x1[2 * j] * cs[1];
            y1[2 * j + 1] = x1[2 * j + 1] * cs[2] - x2[2 * j + 1] * cs[3]; y2[2 * j + 1] = x2[2 * j + 1] * cs[2] + x1[2 * j + 1] * cs[3]; }
        *(u32x4*)p = pack8((f32x4){y1[0], y1[1], y1[2], y1[3]}, (f32x4){y1[4], y1[5], y1[6], y1[7]});
        *(u32x4*)(p + 8) = pack8((f32x4){y2[0], y2[1], y2[2], y2[3]}, (f32x4){y2[4], y2[5], y2[6], y2[7]});
    }
    {
        const int hd = 8 * (gw & 1) + (lane >> 3), c8 = 8 * (lane & 7), hc = hd * 64 + c8;
        f32x4 cw[3][3][2];
#pragma unroll
        for (int part = 0; part < 3; ++part)
#pragma unroll
            for (int i = 0; i < 3; ++i) { cw[part][i][0] = *(const f32x4*)(a.conv + i * 3072 + part * 1024 + hc); cw[part][i][1] = *(const f32x4*)(a.conv + i * 3072 + part * 1024 + hc + 4); }
        const f32x4 kw0 = *(const f32x4*)(a.k_k + hc), kw1 = *(const f32x4*)(a.k_k + hc + 4), rw0 = *(const f32x4*)(a.r_k + hc), rw1 = *(const f32x4*)(a.r_k + hc + 4);
        for (int t0 = gw >> 1; t0 < TCH; t0 += NGW) {
            u32x4 raw[2][3][3];
#pragma unroll
            for (int e = 0; e < 2; ++e) { const int t = t0 + e * (NGW >> 1); if (t >= TCH) continue;
                const int pos = t % S; const bool hasp = pos > 0, hasn = pos < S - 1;
                const bf16_t* hr = H + (size_t)t * PIN + C_RKV + hc;
#pragma unroll
                for (int part = 0; part < 3; ++part) {
                    raw[e][part][1] = *(const u32x4*)(hr + part * 1024);
                    raw[e][part][0] = hasp ? *(const u32x4*)(hr + part * 1024 - PIN) : (u32x4){0u, 0u, 0u, 0u};
                    raw[e][part][2] = hasn ? *(const u32x4*)(hr + part * 1024 + PIN) : (u32x4){0u, 0u, 0u, 0u}; } }
#pragma unroll
            for (int e = 0; e < 2; ++e) { const int t = t0 + e * (NGW >> 1); if (t >= TCH) continue;
                float rkv[3][8];
#pragma unroll
                for (int part = 0; part < 3; ++part) {
                    float xm[8], x0[8], xp[8]; unpack8(raw[e][part][0], xm); unpack8(raw[e][part][1], x0); unpack8(raw[e][part][2], xp);
#pragma unroll
                    for (int i = 0; i < 8; ++i) { const float w0 = cw[part][0][i >> 2][i & 3], w1 = cw[part][1][i >> 2][i & 3], w2 = cw[part][2][i >> 2][i & 3];
                        rkv[part][i] = fmaf(xp[i], w2, fmaf(xm[i], w0, x0[i] * w1)); }
                }
                float kk[8], ss = 0.f, bs = 0.f;
#pragma unroll
                for (int i = 0; i < 8; ++i) { kk[i] = rkv[1][i] * (i < 4 ? kw0[i] : kw1[i - 4]); ss = fmaf(kk[i], kk[i], ss); bs = fmaf(rkv[0][i] * rkv[1][i], (i < 4 ? rw0[i] : rw1[i - 4]), bs); }
                ss += dpp_mov<0xB1>(ss); ss += dpp_mov<0x4E>(ss); ss += dpp_mov<0x141>(ss);
                bs += dpp_mov<0xB1>(bs); bs += dpp_mov<0x4E>(bs); bs += dpp_mov<0x141>(bs);
                const float rn = 1.0f / sqrtf(ss + 1e-12f);
                bf16_t* o = CV + ((size_t)t * 16 + hd) * 256 + c8;
                *(u32x4*)o = pack8((f32x4){rkv[0][0], rkv[0][1], rkv[0][2], rkv[0][3]}, (f32x4){rkv[0][4], rkv[0][5], rkv[0][6], rkv[0][7]});
                *(u32x4*)(o + 64) = pack8((f32x4){rkv[1][0], rkv[1][1], rkv[1][2], rkv[1][3]}, (f32x4){rkv[1][4], rkv[1][5], rkv[1][6], rkv[1][7]});
                *(u32x4*)(o + 128) = pack8((f32x4){rkv[2][0], rkv[2][1], rkv[2][2], rkv[2][3]}, (f32x4){rkv[2][4], rkv[2][5], rkv[2][6], rkv[2][7]});
                *(u32x4*)(o + 192) = pack8((f32x4){kk[0] * rn, kk[1] * rn, kk[2] * rn, kk[3] * rn}, (f32x4){kk[4] * rn, kk[5] * rn, kk[6] * rn, kk[7] * rn});
                if ((lane & 7) == 0) BN[t * 16 + hd] = bs; }
        }
    }
}
namespace att {
constexpr int NW = 8, QBLK = 32, KVBLK = 64;
constexpr float SCALE = 0.125f, THR = 8.f;
constexpr int LDK = PIN, LDO = 2048;
constexpr int SHM_V = KVBLK * 128 * 2, SHM_K = KVBLK * 64 * 2, SHM_ATTN = 2 * SHM_V + 2 * SHM_K + NW * 64 * 4;
#define KSWZ(row, colB) ((row) * 128 + ((colB) ^ (((row) & 7) << 4)))
#define SBAR() __builtin_amdgcn_sched_barrier(0)
__device__ __forceinline__ int crow(int r, int hi) { return (r & 3) + 8 * (r >> 2) + 4 * hi; }
__device__ __forceinline__ void partialSM(f32x16& p0, f32x16& p1, float& m_reg, float& mn, float& alpha) {
  constexpr float C = SCALE * 1.4426950408889634f;
  float pmax = p0[0];
#pragma unroll
  for (int r = 1; r < 16; ++r) pmax = fmaxf(pmax, p0[r]);
#pragma unroll
  for (int r = 0; r < 16; ++r) pmax = fmaxf(pmax, p1[r]);
  { auto rr = __builtin_amdgcn_permlane32_swap(__float_as_uint(pmax), __float_as_uint(pmax), false, false);
    pmax = fmaxf(__uint_as_float(rr[0]), __uint_as_float(rr[1])); }
  if (__builtin_expect(__all(pmax - m_reg <= THR / SCALE), 1)) { mn = m_reg; alpha = 1.f; }
  else { mn = fmaxf(m_reg, pmax); alpha = __builtin_amdgcn_exp2f((m_reg - mn) * C); m_reg = mn; }
  float mnC = -mn * C;
#pragma unroll
  for (int r = 0; r < 16; ++r) p0[r] = fmaf(p0[r], C, mnC);
#pragma unroll
  for (int r = 0; r < 16; ++r) p1[r] = fmaf(p1[r], C, mnC);
#pragma unroll
  for (int r = 0; r < 16; ++r) p0[r] = __builtin_amdgcn_exp2f(p0[r]);
}
__device__ __forceinline__ void finishSM(f32x16& p0, f32x16& p1, float alpha, float& l_reg, bf16x8& pa0, bf16x8& pa1, bf16x8& pa2, bf16x8& pa3) {
#pragma unroll
  for (int r = 0; r < 16; ++r) p1[r] = __builtin_amdgcn_exp2f(p1[r]);
  float ps = 0;
#pragma unroll
  for (int r = 0; r < 16; ++r) ps += p0[r];
#pragma unroll
  for (int r = 0; r < 16; ++r) ps += p1[r];
  { auto rr = __builtin_amdgcn_permlane32_swap(__float_as_uint(ps), __float_as_uint(ps), false, false);
    ps = __uint_as_float(rr[0]) + __uint_as_float(rr[1]); }
  l_reg = l_reg * alpha + ps;
#define PK4(P, BASE, OUT) do { unsigned a0 = cvt_pk_bf16(P[BASE + 0], P[BASE + 1]), a1 = cvt_pk_bf16(P[BASE + 2], P[BASE + 3]);   \
    unsigned b0 = cvt_pk_bf16(P[BASE + 4], P[BASE + 5]), b1 = cvt_pk_bf16(P[BASE + 6], P[BASE + 7]);                              \
    auto r0 = __builtin_amdgcn_permlane32_swap(a0, b0, false, false); auto r1 = __builtin_amdgcn_permlane32_swap(a1, b1, false, false); \
    u32x4 w = {r0[0], r1[0], r0[1], r1[1]}; OUT = *reinterpret_cast<bf16x8*>(&w); } while (0)
  PK4(p0, 0, pa0); PK4(p0, 8, pa1); PK4(p1, 0, pa2); PK4(p1, 8, pa3);
#undef PK4
}
__device__ __forceinline__ void qkt(f32x16& p0, f32x16& p1, const char* Ks, const bf16x8* qr, int r32, int hi) {
  p0 = f32x16{}; p1 = f32x16{};
#pragma unroll
  for (int d0 = 0; d0 < 4; ++d0) { int cb = (d0 * 16 + hi * 8) * 2;
    bf16x8 b0 = *reinterpret_cast<const bf16x8*>(Ks + KSWZ(r32, cb));
    bf16x8 b1 = *reinterpret_cast<const bf16x8*>(Ks + KSWZ(32 + r32, cb));
    p0 = __builtin_amdgcn_mfma_f32_32x32x16_bf16(b0, qr[d0], p0, 0, 0, 0);
    p1 = __builtin_amdgcn_mfma_f32_32x32x16_bf16(b1, qr[d0], p1, 0, 0, 0); }
}
__device__ __forceinline__ int v_st(int k, int c) { const int kk = (k & ~0xC) | ((k & 4) << 1) | ((k & 8) >> 1); return ((kk >> 3) * 4 + (c >> 5)) * 512 + ((kk & 7) * 32 + (c & 31)) * 2; }
__device__ __forceinline__ int v_rd_base(int lane) { return ((lane & 3) << 3) | (((lane >> 2) & 3) << 6) | (((lane >> 4) & 1) << 5) | (((lane >> 5) & 1) << 8); }
constexpr int v_rd_off(int d0, int ks, int half) { return d0 * 512 + ks * 4096 + half * 2048; }
template <int OFF> __device__ __forceinline__ s16x4 tr_read(int vb) {
  s16x4 r; asm volatile("ds_read_b64_tr_b16 %0, %1 offset:%2" : "=&v"(r) : "v"(vb), "i"(OFF) : "memory"); return r;
}
template <int D0> __device__ __forceinline__ void pv_one(f32x16& od, int vb, bf16x8 pa0, bf16x8 pa1, bf16x8 pa2, bf16x8 pa3) {
  const s16x4 l0 = tr_read<v_rd_off(D0, 0, 0)>(vb), h0 = tr_read<v_rd_off(D0, 0, 1)>(vb), l1 = tr_read<v_rd_off(D0, 1, 0)>(vb), h1 = tr_read<v_rd_off(D0, 1, 1)>(vb);
  const s16x4 l2 = tr_read<v_rd_off(D0, 2, 0)>(vb), h2 = tr_read<v_rd_off(D0, 2, 1)>(vb), l3 = tr_read<v_rd_off(D0, 3, 0)>(vb), h3 = tr_read<v_rd_off(D0, 3, 1)>(vb);
  asm volatile("s_waitcnt lgkmcnt(0)" ::: "memory"); SBAR();
#define PK(L, H) (bf16x8){L[0], L[1], L[2], L[3], H[0], H[1], H[2], H[3]}
  od = __builtin_amdgcn_mfma_f32_32x32x16_bf16(pa0, PK(l0, h0), od, 0, 0, 0);
  od = __builtin_amdgcn_mfma_f32_32x32x16_bf16(pa1, PK(l1, h1), od, 0, 0, 0);
  od = __builtin_amdgcn_mfma_f32_32x32x16_bf16(pa2, PK(l2, h2), od, 0, 0, 0);
  od = __builtin_amdgcn_mfma_f32_32x32x16_bf16(pa3, PK(l3, h3), od, 0, 0, 0);
#undef PK
}
__device__ __forceinline__ void pv_d0(f32x16* o, int vb, bf16x8 pa0, bf16x8 pa1, bf16x8 pa2, bf16x8 pa3) {
  pv_one<0>(o[0], vb, pa0, pa1, pa2, pa3); pv_one<1>(o[1], vb, pa0, pa1, pa2, pa3); pv_one<2>(o[2], vb, pa0, pa1, pa2, pa3); pv_one<3>(o[3], vb, pa0, pa1, pa2, pa3);
}
__device__ __forceinline__ void attn_body(const bf16_t* __restrict__ Qb, const bf16_t* __restrict__ Kh, const bf16_t* __restrict__ Vh,
                                          bf16_t* __restrict__ Ob, int seq, char* lds, const int tid) {
  const int wid = tid >> 6, lane = tid & 63, r32 = lane & 31, hi = lane >> 5;
  char* V_lds = lds; char* K_lds = lds + 2 * SHM_V;
  float* ws = (float*)(lds + 2 * SHM_V + 2 * SHM_K) + wid * 64; float* li_l = ws; float* al_l = ws + 32;
  float m_reg = -1e30f, l_reg = 0; f32x16 o[4] = {}; bf16x8 qr[4];
  const bf16_t* Qw = Qb + (long)(wid * QBLK + r32) * LDK + hi * 8;
#pragma unroll
  for (int d0 = 0; d0 < 4; ++d0) qr[d0] = *reinterpret_cast<const bf16x8*>(Qw + d0 * 16);
  const int sr = tid >> 4, sc = (tid & 15) * 8, vst0 = v_st(sr, sc), vst1 = v_st(32 + sr, sc);
  const int kr = tid >> 3, kc = (tid & 7) * 8, kst = KSWZ(kr, kc * 2);
  const int vb0 = (int)(uintptr_t)V_lds + v_rd_base(lane);
  struct { bf16x8 vs0, vs1, ks0; } sr_[2];
  const unsigned vo0 = (unsigned)(sr * LDK + sc), vo1 = (unsigned)((32 + sr) * LDK + sc), ko0 = (unsigned)(kr * LDK + kc);
#define SLOAD(i, k0) do { const bf16_t* Vt_ = Vh + (size_t)(k0) * LDK; const bf16_t* Kt_ = Kh + (size_t)(k0) * LDK; \
    sr_[i].vs0 = *reinterpret_cast<const bf16x8*>(Vt_ + vo0); sr_[i].vs1 = *reinterpret_cast<const bf16x8*>(Vt_ + vo1); \
    sr_[i].ks0 = *reinterpret_cast<const bf16x8*>(Kt_ + ko0); } while (0)
#define SWRITE(b, i) do { *(bf16x8*)(V_lds + (b) * SHM_V + vst0) = sr_[i].vs0; *(bf16x8*)(V_lds + (b) * SHM_V + vst1) = sr_[i].vs1; \
    *(bf16x8*)(K_lds + (b) * SHM_K + kst) = sr_[i].ks0; } while (0)
#define SWAIT() asm volatile("s_waitcnt vmcnt(3)" ::: "memory")
#define RESC(a) do { if (__any((a) < 1.f)) { if (hi == 0) al_l[r32] = (a); asm volatile("s_waitcnt lgkmcnt(0)" ::: "memory"); \
    _Pragma("unroll") for (int d = 0; d < 4; ++d) _Pragma("unroll") for (int r = 0; r < 16; ++r) o[d][r] *= al_l[crow(r, hi)]; } } while (0)
  f32x16 pA0, pA1, pB0, pB1; float mnA, mnB, alA, alB; bf16x8 pa0, pa1, pa2, pa3; const int NT = seq / KVBLK;
  constexpr int SE = 0, SO = 1;
  SLOAD(SE, 0); asm volatile("s_waitcnt vmcnt(0)" ::: "memory"); SWRITE(0, SE); __syncthreads();
  qkt(pA0, pA1, K_lds, qr, r32, hi); partialSM(pA0, pA1, m_reg, mnA, alA);
  SLOAD(SO, KVBLK); if (2 < NT) SLOAD(SE, 2 * KVBLK);
  SWAIT(); SWRITE(1, SO); __syncthreads();
  for (int j = 1; j + 1 < NT; j += 2) {
    SBAR(); qkt(pB0, pB1, K_lds + SHM_K, qr, r32, hi);
    finishSM(pA0, pA1, alA, l_reg, pa0, pa1, pa2, pa3); SBAR();
    SLOAD(SO, (j + 2) * KVBLK); SBAR();
    pv_d0(o, vb0, pa0, pa1, pa2, pa3); partialSM(pB0, pB1, m_reg, mnB, alB);
    __syncthreads(); SWAIT(); SWRITE(0, SE);
    RESC(alB); __syncthreads();
    SBAR(); qkt(pA0, pA1, K_lds, qr, r32, hi);
    finishSM(pB0, pB1, alB, l_reg, pa0, pa1, pa2, pa3); SBAR();
    if (j + 3 < NT) SLOAD(SE, (j + 3) * KVBLK); SBAR();
    pv_d0(o, vb0 + (int)SHM_V, pa0, pa1, pa2, pa3); partialSM(pA0, pA1, m_reg, mnA, alA);
    __syncthreads(); SWAIT(); SWRITE(1, SO);
    RESC(alA); __syncthreads();
  }
  SBAR(); qkt(pB0, pB1, K_lds + SHM_K, qr, r32, hi);
  finishSM(pA0, pA1, alA, l_reg, pa0, pa1, pa2, pa3); SBAR();
  pv_d0(o, vb0, pa0, pa1, pa2, pa3); partialSM(pB0, pB1, m_reg, mnB, alB);
  __syncthreads(); RESC(alB);
  finishSM(pB0, pB1, alB, l_reg, pa0, pa1, pa2, pa3); SBAR();
  pv_d0(o, vb0 + (int)SHM_V, pa0, pa1, pa2, pa3);
  if (hi == 0) li_l[r32] = l_reg; asm volatile("s_waitcnt lgkmcnt(0)" ::: "memory");
  float rli[16];
#pragma unroll
  for (int r = 0; r < 16; ++r) rli[r] = __builtin_amdgcn_rcpf(li_l[crow(r, hi)]);
  bf16_t* Ow = Ob + (long)(wid * QBLK) * LDO;
  { bf16_t* stg = (bf16_t*)(lds + 53248) + wid * 4096;
#pragma unroll
    for (int r = 0; r < 16; ++r) { const int orow = crow(r, hi);
#pragma unroll
      for (int d0 = 0; d0 < 4; ++d0) stg[orow * 128 + d0 * 32 + r32] = (bf16_t)(cvt_pk_bf16(o[d0][r] * rli[r], 0.f) & 0xffffu); }
    asm volatile("s_waitcnt lgkmcnt(0)" ::: "memory");
#pragma unroll
    for (int j = 0; j < 8; ++j) { const int idx = j * 64 + lane, row = idx >> 4, ch = idx & 15;
      *(u32x4*)(Ow + (long)row * LDO + ch * 8) = *(const u32x4*)(stg + row * 128 + ch * 8); } }
  __syncthreads();
#undef SLOAD
#undef SWRITE
#undef SWAIT
#undef RESC
}
#undef SBAR
}

constexpr int SCAN_TB = 32, SCAN_STEP_B = 6 * 64 * 4, SCAN_BUF_B = SCAN_TB * SCAN_STEP_B;
#define DPP_Q1 "quad_perm:[1,0,3,2] row_mask:0xf bank_mask:0xf"
#define DPP_Q2 "quad_perm:[2,3,0,1] row_mask:0xf bank_mask:0xf"
#define DPP_HM "row_half_mirror row_mask:0xf bank_mask:0xf"
#define DPP_RM "row_mirror row_mask:0xf bank_mask:0xf"
__device__ __forceinline__ void allreduce16x4(float& a, float& b, float& c, float& d) {
    asm volatile("s_nop 1\n\t"
        "v_add_f32_dpp %0, %0, %0 " DPP_Q1 "\n\tv_add_f32_dpp %1, %1, %1 " DPP_Q1 "\n\tv_add_f32_dpp %2, %2, %2 " DPP_Q1 "\n\tv_add_f32_dpp %3, %3, %3 " DPP_Q1 "\n\t"
        "v_add_f32_dpp %0, %0, %0 " DPP_Q2 "\n\tv_add_f32_dpp %1, %1, %1 " DPP_Q2 "\n\tv_add_f32_dpp %2, %2, %2 " DPP_Q2 "\n\tv_add_f32_dpp %3, %3, %3 " DPP_Q2 "\n\t"
        "v_add_f32_dpp %0, %0, %0 " DPP_HM "\n\tv_add_f32_dpp %1, %1, %1 " DPP_HM "\n\tv_add_f32_dpp %2, %2, %2 " DPP_HM "\n\tv_add_f32_dpp %3, %3, %3 " DPP_HM "\n\t"
        "v_add_f32_dpp %0, %0, %0 " DPP_RM "\n\tv_add_f32_dpp %1, %1, %1 " DPP_RM "\n\tv_add_f32_dpp %2, %2, %2 " DPP_RM "\n\tv_add_f32_dpp %3, %3, %3 " DPP_RM "\n\t"
        : "+v"(a), "+v"(b), "+v"(c), "+v"(d));
}
__device__ __forceinline__ void allreduce16x2(float& a, float& b) {
    asm volatile("s_nop 1\n\t"
        "v_add_f32_dpp %0, %0, %0 " DPP_Q1 "\n\tv_add_f32_dpp %1, %1, %1 " DPP_Q1 "\n\ts_nop 0\n\t"
        "v_add_f32_dpp %0, %0, %0 " DPP_Q2 "\n\tv_add_f32_dpp %1, %1, %1 " DPP_Q2 "\n\ts_nop 0\n\t"
        "v_add_f32_dpp %0, %0, %0 " DPP_HM "\n\tv_add_f32_dpp %1, %1, %1 " DPP_HM "\n\ts_nop 0\n\t"
        "v_add_f32_dpp %0, %0, %0 " DPP_RM "\n\tv_add_f32_dpp %1, %1, %1 " DPP_RM "\n\t"
        : "+v"(a), "+v"(b));
}
__device__ __forceinline__ void allreduce8x4(float& a, float& b, float& c, float& d) {
    asm volatile("s_nop 1\n\t"
        "v_add_f32_dpp %0, %0, %0 " DPP_Q1 "\n\tv_add_f32_dpp %1, %1, %1 " DPP_Q1 "\n\tv_add_f32_dpp %2, %2, %2 " DPP_Q1 "\n\tv_add_f32_dpp %3, %3, %3 " DPP_Q1 "\n\t"
        "v_add_f32_dpp %0, %0, %0 " DPP_Q2 "\n\tv_add_f32_dpp %1, %1, %1 " DPP_Q2 "\n\tv_add_f32_dpp %2, %2, %2 " DPP_Q2 "\n\tv_add_f32_dpp %3, %3, %3 " DPP_Q2 "\n\t"
        "v_add_f32_dpp %0, %0, %0 " DPP_HM "\n\tv_add_f32_dpp %1, %1, %1 " DPP_HM "\n\tv_add_f32_dpp %2, %2, %2 " DPP_HM "\n\tv_add_f32_dpp %3, %3, %3 " DPP_HM "\n\t"
        : "+v"(a), "+v"(b), "+v"(c), "+v"(d));
}
__device__ __forceinline__ void allreduce8x2(float& a, float& b) {
    asm volatile("s_nop 1\n\t"
        "v_add_f32_dpp %0, %0, %0 " DPP_Q1 "\n\tv_add_f32_dpp %1, %1, %1 " DPP_Q1 "\n\ts_nop 0\n\t"
        "v_add_f32_dpp %0, %0, %0 " DPP_Q2 "\n\tv_add_f32_dpp %1, %1, %1 " DPP_Q2 "\n\ts_nop 0\n\t"
        "v_add_f32_dpp %0, %0, %0 " DPP_HM "\n\tv_add_f32_dpp %1, %1, %1 " DPP_HM "\n\t"
        : "+v"(a), "+v"(b));
}
template <int R>
__device__ __forceinline__ void scan_unit(const Args& a, int b_loc, int head, int dir, int rbase, int S, LAS unsigned char* lds, const int tid) {
    const int ls = tid >> 4, lc = tid & 15;
    unsigned char* ws = a.ws;
    const bf16_t* CV = (const bf16_t*)(ws + WS_CONV); const bf16_t* LO = (const bf16_t*)(ws + WS_LORA);
    float* O = (float*)(ws + (dir ? WS_OB : WS_OF));
    const long rowbase = (long)b_loc * S;
    const f32x4 ka = *(const f32x4*)(a.k_a + head * 64 + 4 * lc);
    const int NB = S / SCAN_TB;
    u32x2 lr, lk, lv, lkk, lu, la, lkn;
#define SC_TOKI(i) (rowbase + (dir ? (S - 1 - (i)) : (i)))
#define SC_LOAD(blk) do { const int i_ = (blk) * SCAN_TB + ls; const long tk_ = SC_TOKI(i_), tn_ = SC_TOKI(i_ + 1 < S ? i_ + 1 : i_); \
        const bf16_t* cv_ = CV + (tk_ * 16 + head) * 256 + 4 * lc; const bf16_t* lo_ = LO + tk_ * 4096 + dir * 1024 + head * 64 + 4 * lc; \
        lr = *(const u32x2*)(cv_); lk = *(const u32x2*)(cv_ + 64); lv = *(const u32x2*)(cv_ + 128); lkk = *(const u32x2*)(cv_ + 192); lu = *(const u32x2*)(lo_); la = *(const u32x2*)(lo_ + 2048); \
        lkn = *(const u32x2*)(CV + (tn_ * 16 + head) * 256 + 192 + 4 * lc); } while (0)
#define SC_WRITE(buf) do { const f32x4 r_ = unp4(lr), k_ = unp4(lk), v_ = unp4(lv), kk_ = unp4(lkk), u_ = unp4(lu), a_ = unp4(la), kn_ = unp4(lkn); \
        LAS f32x4* p_ = (LAS f32x4*)(lds + (buf) * SCAN_BUF_B + ls * SCAN_STEP_B); \
        p_[lc] = u_; p_[16 + lc] = kk_ * a_; p_[32 + lc] = k_ * (1.0f + (a_ - 1.0f) * ka); \
        p_[48 + 2 * lc] = (f32x4){r_[0], -kn_[0], r_[1], -kn_[1]}; p_[48 + 2 * lc + 1] = (f32x4){r_[2], -kn_[2], r_[3], -kn_[3]}; p_[80 + lc] = v_; } while (0)
    const int g = tid >> 3, c = tid & 7;
    const bool worker = tid < 256;
    f32x2 s2[R][4];
    float sa[2] = {0.f, 0.f}, ok[2] = {0.f, 0.f};
#pragma unroll
    for (int j = 0; j < R; ++j)
#pragma unroll
        for (int i = 0; i < 4; ++i) s2[j][i] = (f32x2){0.f, 0.f};
    SC_LOAD(0); SC_WRITE(0); __syncthreads();
    float* Ocol = O + head * 64 + rbase + R * g;
    for (int blk = 0; blk < NB; ++blk) {
        if (blk + 1 < NB) SC_LOAD(blk + 1);
        if (worker) {
            const LAS unsigned char* bp = lds + (blk & 1) * SCAN_BUF_B;
#pragma unroll 2
            for (int st = 0; st < SCAN_TB; ++st) {
                const LAS f32x4* p = (const LAS f32x4*)(bp + st * SCAN_STEP_B);
                const f32x4 u0 = p[2 * c], u1 = p[2 * c + 1], b0 = p[16 + 2 * c], b1 = p[16 + 2 * c + 1], k0 = p[32 + 2 * c], k1 = p[32 + 2 * c + 1];
                const f32x4 rn0 = p[48 + 4 * c], rn1 = p[48 + 4 * c + 1], rn2 = p[48 + 4 * c + 2], rn3 = p[48 + 4 * c + 3];
                float vv[2];
                if (R == 2) { const f32x2 v2 = *(const LAS f32x2*)(bp + st * SCAN_STEP_B + 1280 + (rbase + 2 * g) * 4); vv[0] = v2[0]; vv[1] = v2[1]; }
                else { vv[0] = *(const LAS float*)(bp + st * SCAN_STEP_B + 1280 + (rbase + g) * 4); vv[1] = 0.f; }
                const f32x2 uu[4] = {(f32x2){u0[0], u0[1]}, (f32x2){u0[2], u0[3]}, (f32x2){u1[0], u1[1]}, (f32x2){u1[2], u1[3]}};
                const f32x2 bb[4] = {(f32x2){b0[0], b0[1]}, (f32x2){b0[2], b0[3]}, (f32x2){b1[0], b1[1]}, (f32x2){b1[2], b1[3]}};
                const f32x2 kd[4] = {(f32x2){k0[0], k0[1]}, (f32x2){k0[2], k0[3]}, (f32x2){k1[0], k1[1]}, (f32x2){k1[2], k1[3]}};
                const f32x4 rn[4] = {rn0, rn1, rn2, rn3};
                float o[2] = {0.f, 0.f}, sn[2] = {0.f, 0.f};
#pragma unroll
                for (int j = 0; j < R; ++j) {
                    f32x2 acc = (f32x2){0.f, 0.f};
#pragma unroll
                    for (int i = 0; i < 4; ++i) {
                        f32x2 t = s2[j][i] - s2[j][i] * uu[i]; t = t + sa[j] * bb[i]; t = t + vv[j] * kd[i]; s2[j][i] = t;
                        acc = acc + t[0] * (f32x2){rn[i][0], rn[i][1]}; acc = acc + t[1] * (f32x2){rn[i][2], rn[i][3]};
                    }
                    o[j] = acc[0]; sn[j] = acc[1];
                }
                if (R == 2) allreduce8x4(o[0], o[1], sn[0], sn[1]); else allreduce8x2(o[0], sn[0]);
                sa[0] = sn[0]; sa[1] = sn[1];
                const bool mine = ((st & 7) == c);
                ok[0] = mine ? o[0] : ok[0]; if (R == 2) ok[1] = mine ? o[1] : ok[1];
                if ((st & 7) == 7) {
                    float* op = Ocol + SC_TOKI(blk * SCAN_TB + (st & 24) + c) * 1024;
                    if (R == 2) *(f32x2*)op = (f32x2){ok[0], ok[1]}; else *op = ok[0];
                }
            }
        }
        if (blk + 1 < NB) SC_WRITE((blk + 1) & 1);
        __syncthreads();
    }
#undef SC_TOKI
#undef SC_LOAD
#undef SC_WRITE
}

namespace cs {
constexpr int SA = 64, SB = 32, SV = 16;
constexpr int SAR = 72;
constexpr int O_AR = 0, O_BKT = 4608, O_VT = 8704, O_GM = 10752, O_XT = 12800, O_GC = 13824, SLOT_B = 14080;
constexpr int NPROD = 5;
constexpr int O_PSCR = 2 * NPROD * SLOT_B, PSCR_B = 1024, O_CSCR = O_PSCR + NPROD * PSCR_B, CSCR_B = 0;
static_assert(O_CSCR + 2 * CSCR_B <= LDS_BYTES - 64, "scan LDS map");
__device__ __forceinline__ int crow(int r, int hi) { return (r & 3) + 8 * (r >> 2) + 4 * hi; }
__device__ __forceinline__ bf16_t tobf(float x) { return (bf16_t)(cvt_pk_bf16(x, 0.f) & 0xffffu); }
#define CS_LWAIT() asm volatile("s_waitcnt lgkmcnt(0)" ::: "memory")

struct PRaw { u32x4 c[8]; u32x4 o[4]; };
__device__ __forceinline__ void produce_load(PRaw& R, const Args& a, long rowbase, int head, int dir, int S, int q, int l) {
    const bf16_t* CV = (const bf16_t*)(a.ws + WS_CONV); const bf16_t* LO = (const bf16_t*)(a.ws + WS_LORA);
#pragma unroll
    for (int j = 0; j < 8; ++j) { const int t = 2 * j + (l >> 5), i = 16 * q + t; const long tok = rowbase + (dir ? (S - 1 - i) : i);
        R.c[j] = __builtin_nontemporal_load((const u32x4*)(CV + (tok * 16 + head) * 256 + (l & 31) * 8)); }
#pragma unroll
    for (int j = 0; j < 4; ++j) { const int t = 4 * j + (l >> 4), i = 16 * q + t; const long tok = rowbase + (dir ? (S - 1 - i) : i);
        R.o[j] = __builtin_nontemporal_load((const u32x4*)(LO + tok * 4096 + dir * 1024 + head * 64 + ((l >> 3) & 1) * 2048 + (l & 7) * 8)); }
}
__device__ __forceinline__ void produce_build(const PRaw& R, const Args& a, LAS unsigned char* slot, LAS unsigned char* scr, int head, int l) {
    LAS bf16_t* AR = (LAS bf16_t*)(slot + O_AR); LAS bf16_t* BKt = (LAS bf16_t*)(slot + O_BKT); LAS bf16_t* Vt = (LAS bf16_t*)(slot + O_VT);
    LAS bf16_t* GM = (LAS bf16_t*)(slot + O_GM); LAS bf16_t* XT = (LAS bf16_t*)(slot + O_XT);
    LAS float* GC = (LAS float*)(slot + O_GC); LAS bf16_t* BK = (LAS bf16_t*)(slot + O_VT); LAS float* NM = (LAS float*)scr;
    const float ka = a.k_a[head * 64 + l];
    const int pl = (l & 32) | (((l >> 4) & 1) << 4) | (((l >> 2) & 1) << 3) | (((l >> 3) & 1) << 2) | (l & 3);
    { LAS unsigned char* raw = (LAS unsigned char*)slot;
#pragma unroll
      for (int j = 0; j < 8; ++j) *(LAS u32x4*)(raw + (2 * j + (l >> 5)) * 512 + (l & 31) * 16) = R.c[j];
#pragma unroll
      for (int j = 0; j < 4; ++j) *(LAS u32x4*)(raw + 8192 + (4 * j + (l >> 4)) * 256 + ((l >> 3) & 1) * 128 + (l & 7) * 16) = R.o[j]; }
    CS_LWAIT();
    bf16_t Lr[16], Lk[16], Lv[16], Lkk[16], Lu[16], La[16];
    { const LAS bf16_t* raw = (const LAS bf16_t*)slot;
#pragma unroll
      for (int t = 0; t < 16; ++t) { Lr[t] = raw[t * 256 + l]; Lk[t] = raw[t * 256 + 64 + l]; Lv[t] = raw[t * 256 + 128 + l]; Lkk[t] = raw[t * 256 + 192 + l];
          Lu[t] = raw[4096 + t * 128 + l]; La[t] = raw[4096 + t * 128 + 64 + l]; } }
    CS_LWAIT();
    float g = 1.0f, ig = 1.0f;
    u32x4 pb[2], pk[2], pv[2];
#pragma unroll
    for (int t2 = 0; t2 < 8; ++t2) {
        float ah[2], rh[2], bh[2], kh[2];
#pragma unroll
        for (int e = 0; e < 2; ++e) { const int t = 2 * t2 + e;
            const float r = bf1(Lr[t]), k = bf1(Lk[t]), kk = bf1(Lkk[t]), u = bf1(Lu[t]), aa = bf1(La[t]);
            const float gp = g, w_ = 1.0f - u; g = g * w_; ig = ig * __builtin_amdgcn_rcpf(w_);
            ah[e] = -kk * gp; rh[e] = r * g; bh[e] = kk * aa * ig; kh[e] = k * (1.0f + (aa - 1.0f) * ka) * ig; }
        const unsigned wa = cvt_pk_bf16(ah[0], ah[1]), wr = cvt_pk_bf16(rh[0], rh[1]), wb = cvt_pk_bf16(bh[0], bh[1]), wk = cvt_pk_bf16(kh[0], kh[1]);
        const int t = 2 * t2;
        AR[t * SAR + pl] = (bf16_t)(wa & 0xffffu); AR[(t + 1) * SAR + pl] = (bf16_t)(wa >> 16);
        AR[(16 + t) * SAR + pl] = (bf16_t)(wr & 0xffffu); AR[(17 + t) * SAR + pl] = (bf16_t)(wr >> 16);
        BK[t * SA + pl] = (bf16_t)(wb & 0xffffu); BK[(t + 1) * SA + pl] = (bf16_t)(wb >> 16);
        BK[(16 + t) * SA + pl] = (bf16_t)(wk & 0xffffu); BK[(17 + t) * SA + pl] = (bf16_t)(wk >> 16);
        { constexpr int pp[8] = {0, 1, 4, 5, 2, 3, 6, 7}; pb[pp[t2] >> 2][pp[t2] & 3] = wb; }
        pk[t2 >> 2][t2 & 3] = wk;
        pv[t2 >> 2][t2 & 3] = ((unsigned)Lv[t]) | (((unsigned)Lv[t + 1]) << 16);
    }
    { LAS u32x4* bt = (LAS u32x4*)(BKt + l * SB); bt[0] = pb[0]; bt[1] = pb[1]; bt[2] = pk[0]; bt[3] = pk[1]; }
    GC[l] = g;
    CS_LWAIT();
    const int n = l & 31, hi = l >> 5;
    f32x16 G = {};
#pragma unroll
    for (int ks = 0; ks < 4; ++ks) {
        const bf16x8 fa = *(const LAS bf16x8*)(AR + n * SAR + 16 * ks + 8 * hi), fb = *(const LAS bf16x8*)(BK + n * SA + 16 * ks + 8 * hi);
        G = __builtin_amdgcn_mfma_f32_32x32x16_bf16(fa, fb, G, 0, 0, 0);
    }
    CS_LWAIT();
    { LAS u32x4* vt = (LAS u32x4*)(Vt + l * SV); vt[0] = pv[0]; vt[1] = pv[1]; }
#pragma unroll
    for (int r = 0; r < 16; ++r) {
        const int tp = crow(r, hi); const float val = G[r];
        const int j = n & 15;
        const bool keep = (r < 8) ? ((n >= 16) && (j < tp)) : (j <= tp - 16);
        const int gcol = (n < 16) ? ((((n >> 2) & 1) << 3) | ((n >> 3) << 2) | (n & 3)) : n;
        GM[tp * SB + gcol] = keep ? tobf(val) : (bf16_t)0;
    }
    if (n < 16) {
#pragma unroll
        for (int r = 0; r < 8; ++r) { const int tp = crow(r, hi); NM[tp * 16 + n] = (n < tp) ? G[r] : 0.f; }
    }
    { const int rr = 16 + (l >> 2), cc = (l & 3) * 4; LAS u32x2* z = (LAS u32x2*)(XT + rr * SV + cc); *z = (u32x2){0u, 0u}; }
    CS_LWAIT();
    { const int c = l & 15; float x[16];
#pragma unroll
      for (int t = 0; t < 16; ++t) {
          const f32x4 n0 = *(const LAS f32x4*)(NM + t * 16), n1 = *(const LAS f32x4*)(NM + t * 16 + 4), n2 = *(const LAS f32x4*)(NM + t * 16 + 8), n3 = *(const LAS f32x4*)(NM + t * 16 + 12);
          const float nr[16] = {n0[0], n0[1], n0[2], n0[3], n1[0], n1[1], n1[2], n1[3], n2[0], n2[1], n2[2], n2[3], n3[0], n3[1], n3[2], n3[3]};
          float ac[4] = {(t == c) ? 1.0f : 0.0f, 0.f, 0.f, 0.f};
#pragma unroll
          for (int j = 0; j < t; ++j) ac[j & 3] = fmaf(nr[j], x[j], ac[j & 3]);
          x[t] = (ac[0] + ac[1]) + (ac[2] + ac[3]);
      }
      if (l < 16) {
#pragma unroll
          for (int t = 0; t < 16; ++t) XT[t * SV + ((((c >> 2) & 1) << 3) | ((c >> 3) << 2) | (c & 3))] = tobf(x[t]);
      } }
    CS_LWAIT();
}

__device__ __forceinline__ bf16x8 pack_acc8(const f32x16& d, int base) {
    u32x4 w; w.x = cvt_pk_bf16(d[base + 0], d[base + 1]); w.y = cvt_pk_bf16(d[base + 2], d[base + 3]); w.z = cvt_pk_bf16(d[base + 4], d[base + 5]); w.w = cvt_pk_bf16(d[base + 6], d[base + 7]);
    return __builtin_bit_cast(bf16x8, w);
}
__device__ __forceinline__ void consume(const LAS unsigned char* slot, f32x16 (&DS)[2], bf16_t* Obase, long rowoff, int dir, int S, int q, int cw, int l) {
    const LAS bf16_t* AR = (const LAS bf16_t*)(slot + O_AR); const LAS bf16_t* BKt = (const LAS bf16_t*)(slot + O_BKT); const LAS bf16_t* Vt = (const LAS bf16_t*)(slot + O_VT);
    const LAS bf16_t* GM = (const LAS bf16_t*)(slot + O_GM); const LAS bf16_t* XT = (const LAS bf16_t*)(slot + O_XT);
    const LAS float* GC = (const LAS float*)(slot + O_GC);
    const int n = l & 31, hi = l >> 5;
    bf16x8 aA[4], aK0[2], aK1[2]; f32x4 gc[2][4];
#pragma unroll
    for (int i = 0; i < 4; ++i) aA[i] = *(const LAS bf16x8*)(AR + n * SAR + 16 * i + 8 * hi);
    const bf16x8 bV = *(const LAS bf16x8*)(Vt + (32 * cw + n) * SV + 8 * hi);
    const bf16x8 aAK = *(const LAS bf16x8*)(GM + n * SB + 16 + 8 * hi), aARB = *(const LAS bf16x8*)(GM + n * SB + 8 * hi), aX = *(const LAS bf16x8*)(XT + n * SV + 8 * hi);
#pragma unroll
    for (int bm = 0; bm < 2; ++bm) { aK0[bm] = *(const LAS bf16x8*)(BKt + (32 * bm + n) * SB + 8 * hi); aK1[bm] = *(const LAS bf16x8*)(BKt + (32 * bm + n) * SB + 16 + 8 * hi);
#pragma unroll
        for (int g4 = 0; g4 < 4; ++g4) gc[bm][g4] = *(const LAS f32x4*)(GC + 32 * bm + 8 * g4 + 4 * hi); }
    f32x16 D1 = {};
#pragma unroll
    for (int bm = 0; bm < 2; ++bm)
#pragma unroll
        for (int sp = 0; sp < 2; ++sp) D1 = __builtin_amdgcn_mfma_f32_32x32x16_bf16(aA[2 * bm + sp], pack_acc8(DS[bm], 8 * sp), D1, 0, 0, 0);
    D1 = __builtin_amdgcn_mfma_f32_32x32x16_bf16(aAK, bV, D1, 0, 0, 0);
    f32x16 UA = {};
    UA = __builtin_amdgcn_mfma_f32_32x32x16_bf16(aX, pack_acc8(D1, 0), UA, 0, 0, 0);
    const bf16x8 bU = pack_acc8(UA, 0);
    D1 = __builtin_amdgcn_mfma_f32_32x32x16_bf16(aARB, bU, D1, 0, 0, 0);
#pragma unroll
    for (int bm = 0; bm < 2; ++bm) {
        DS[bm] = __builtin_amdgcn_mfma_f32_32x32x16_bf16(aK0[bm], bU, DS[bm], 0, 0, 0);
        DS[bm] = __builtin_amdgcn_mfma_f32_32x32x16_bf16(aK1[bm], bV, DS[bm], 0, 0, 0);
#pragma unroll
        for (int r = 0; r < 16; ++r) DS[bm][r] *= gc[bm][r >> 2][r & 3];
    }
    if (dir) { bf16_t* p0 = Obase + (rowoff + (S - 1 - 16 * q) - 4 * hi) * 1024 + n;
#pragma unroll
        for (int r = 8; r < 16; ++r) p0[-1024 * ((r & 3) + 8 * ((r >> 2) - 2))] = tobf(D1[r]);
    } else { bf16_t* p0 = Obase + (rowoff + 16 * q + 4 * hi) * 1024 + n;
#pragma unroll
        for (int r = 8; r < 16; ++r) p0[1024 * ((r & 3) + 8 * ((r >> 2) - 2))] = tobf(D1[r]);
    }
}

__device__ __forceinline__ void aux_rows(const float* __restrict__ xnext, bf16_t* __restrict__ xn_out, const f32x4 (&gn)[4], float* __restrict__ oprev, const f32x4 (&gf)[4],
                                         int rb, int re, int l) {
    f32x4 vx[3][4], vo[3][4];
#pragma unroll
    for (int i = 0; i < 3; ++i) { const int row = rb + i;
        if (row < re) {
            if (xnext) {
#pragma unroll
                for (int j = 0; j < 4; ++j) vx[i][j] = __builtin_nontemporal_load((const f32x4*)(xnext + (size_t)row * DM) + l + 64 * j); }
            if (oprev) {
#pragma unroll
                for (int j = 0; j < 4; ++j) vo[i][j] = __builtin_nontemporal_load((const f32x4*)(oprev + (size_t)row * DM) + l + 64 * j); }
        } }
#pragma unroll
    for (int i = 0; i < 3; ++i) { const int row = rb + i;
        if (row < re) {
            if (xnext) { float sx = 0.f;
#pragma unroll
                for (int j = 0; j < 4; ++j) sx += (vx[i][j].x * vx[i][j].x + vx[i][j].y * vx[i][j].y) + (vx[i][j].z * vx[i][j].z + vx[i][j].w * vx[i][j].w);
                const float rstd = 1.0f / sqrtf(wave_sum(sx) * (1.f / DM) + 1e-6f);
                u32x2* o8 = (u32x2*)(xn_out + (size_t)row * DM) + l;
#pragma unroll
                for (int j = 0; j < 4; ++j) { u32x2 w; w.x = cvt_pk_bf16(vx[i][j].x * rstd * gn[j].x, vx[i][j].y * rstd * gn[j].y); w.y = cvt_pk_bf16(vx[i][j].z * rstd * gn[j].z, vx[i][j].w * rstd * gn[j].w); o8[64 * j] = w; } }
            if (oprev) { float so = 0.f;
#pragma unroll
                for (int j = 0; j < 4; ++j) so += (vo[i][j].x * vo[i][j].x + vo[i][j].y * vo[i][j].y) + (vo[i][j].z * vo[i][j].z + vo[i][j].w * vo[i][j].w);
                const float rstd = 1.0f / sqrtf(wave_sum(so) * (1.f / DM) + 1e-6f);
                f32x4* op = (f32x4*)(oprev + (size_t)row * DM) + l;
#pragma unroll
                for (int j = 0; j < 4; ++j) __builtin_nontemporal_store(vo[i][j] * rstd * gf[j], op + 64 * j); }
        } }
}

__device__ __forceinline__ void scan_unit(const Args& a, int b_loc, int head, int dir, int S, LAS unsigned char* lds, const int tid,
                                          const float* xnext, bf16_t* xn_out, float* oprev, const int arow0, const int arows) {
    const int wv = __builtin_amdgcn_readfirstlane(tid >> 6), l = tid & 63;
    const long rowbase = (long)b_loc * S;
    const int NCH = S / 16, NG = (NCH + NPROD - 1) / NPROD;
    bf16_t* O = (bf16_t*)(a.ws + (dir ? WS_OB : WS_OF));
    f32x16 DS[2] = {};
    const bool prod = (wv >= 2 && wv < 2 + NPROD);
    PRaw R;
    if (prod) { produce_load(R, a, rowbase, head, dir, S, wv - 2, l);
                produce_build(R, a, lds + (wv - 2) * SLOT_B, lds + O_PSCR + (wv - 2) * PSCR_B, head, l);
                produce_load(R, a, rowbase, head, dir, S, NPROD + (wv - 2), l); }
    f32x4 gn[4], gf[4];
    if (wv == 7) {
#pragma unroll
        for (int j = 0; j < 4; ++j) { gn[j] = ((const f32x4*)a.norm_g)[l + 64 * j]; gf[j] = ((const f32x4*)a.final_g)[l + 64 * j]; } }
    __syncthreads();
    for (int g = 0; g < NG; ++g) {
        int l2 = l; asm volatile("" : "+v"(l2));
        if (wv == 7) aux_rows(xnext, xn_out, gn, oprev, gf, arow0 + (g * arows) / NG, arow0 + ((g + 1) * arows) / NG, l2);
        else if (prod) { const int q = NPROD * (g + 1) + (wv - 2);
            if (q < NCH) { produce_build(R, a, lds + (((g + 1) & 1) * NPROD + (wv - 2)) * SLOT_B, lds + O_PSCR + (wv - 2) * PSCR_B, head, l2);
                           if (q + NPROD < NCH) produce_load(R, a, rowbase, head, dir, S, q + NPROD, l2); } }
        else if (wv < 2) {
            for (int c = 0; c < NPROD; ++c) { const int q = NPROD * g + c; int l3 = l2; asm volatile("" : "+v"(l3));
                if (q < NCH) consume(lds + ((g & 1) * NPROD + c) * SLOT_B, DS, O + head * 64 + 32 * wv, rowbase, dir, S, q, wv, l3); }
        }
        __syncthreads();
    }
}
}

__device__ __forceinline__ void phase_post(const Args& a, int gw, int NGW, int lane) {
    unsigned char* ws = a.ws;
    const bf16_t* H = (const bf16_t*)(ws + WS_H); const bf16_t* AT = (const bf16_t*)(ws + WS_ATT);
    const bf16_t* OF = (const bf16_t*)(ws + WS_OF); const bf16_t* OB = (const bf16_t*)(ws + WS_OB);
    const bf16_t* CV = (const bf16_t*)(ws + WS_CONV); const float* BN = (const float*)(ws + WS_BONUS);
    bf16_t* OA = (bf16_t*)(ws + WS_OA); bf16_t* ORG = (bf16_t*)(ws + WS_ORG);
    const float d1 = wave_sum(a.lq1[lane] * a.lk1[lane]), d2 = wave_sum(a.lq2[lane] * a.lk2[lane]);
    const float lam = expf(d1) - expf(d2) + 0.2f;
    const int q = lane >> 4, l16 = lane & 15;
    {
        const f32x4 sg0 = *(const f32x4*)(a.subln_g + 8 * l16) * 0.8f, sg1 = *(const f32x4*)(a.subln_g + 8 * l16 + 4) * 0.8f;
        for (int it0 = gw * 4 + q; it0 < TCH * 8; it0 += NGW * 8) {
            u32x4 ra[2], rb[2], rg[2];
#pragma unroll
            for (int e = 0; e < 2; ++e) { const int it = it0 + e * NGW * 4, t = it >> 3, h = it & 7; if (it >= TCH * 8) continue;
                const bf16_t* p1 = AT + (size_t)t * 2048 + (h * 2) * 128 + 8 * l16;
                ra[e] = __builtin_nontemporal_load((const u32x4*)p1); rb[e] = __builtin_nontemporal_load((const u32x4*)(p1 + 128)); rg[e] = __builtin_nontemporal_load((const u32x4*)(H + (size_t)t * PIN + C_GA + h * 128 + 8 * l16)); }
#pragma unroll
            for (int e = 0; e < 2; ++e) { const int it = it0 + e * NGW * 4, t = it >> 3, h = it & 7; if (it >= TCH * 8) continue;
                float fa[8], fb[8], gt[8]; unpack8(ra[e], fa); unpack8(rb[e], fb); unpack8(rg[e], gt);
                float x[8], ss = 0.f;
#pragma unroll
                for (int i = 0; i < 8; ++i) { x[i] = fa[i] - lam * fb[i]; ss = fmaf(x[i], x[i], ss); }
                ss = allreduce16(ss);
                const float rstd = 1.0f / sqrtf(ss * (1.0f / 128.0f) + 1e-5f);
                float y[8];
#pragma unroll
                for (int i = 0; i < 8; ++i) y[i] = x[i] * rstd * (i < 4 ? sg0[i] : sg1[i - 4]) * gt[i] * fsigmoid(gt[i]);
                *(u32x4*)(OA + (size_t)t * 2048 + h * 128 + 8 * l16) = pack8((f32x4){y[0], y[1], y[2], y[3]}, (f32x4){y[4], y[5], y[6], y[7]}); }
        }
    }
    {
        const int hd = 8 * (gw & 1) + (lane >> 3), hc = hd * 64 + 8 * (lane & 7);
        const f32x4 lg0 = *(const f32x4*)(a.lnx_g + hc), lg1 = *(const f32x4*)(a.lnx_g + hc + 4), lb0 = *(const f32x4*)(a.lnx_b + hc), lb1 = *(const f32x4*)(a.lnx_b + hc + 4);
        for (int t0 = gw >> 1; t0 < TCH; t0 += NGW) {
            u32x4 r_of[2], r_ob[2], r_v[2], r_g[2]; float r_bn[2];
#pragma unroll
            for (int e = 0; e < 2; ++e) { const int t = t0 + e * (NGW >> 1); if (t >= TCH) continue;
                r_of[e] = __builtin_nontemporal_load((const u32x4*)(OF + (size_t)t * DM + hc)); r_ob[e] = __builtin_nontemporal_load((const u32x4*)(OB + (size_t)t * DM + hc));
                r_v[e] = __builtin_nontemporal_load((const u32x4*)(CV + ((size_t)t * 16 + hd) * 256 + 128 + 8 * (lane & 7))); r_g[e] = __builtin_nontemporal_load((const u32x4*)(H + (size_t)t * PIN + C_GR + hc)); r_bn[e] = BN[t * 16 + hd]; }
#pragma unroll
            for (int e = 0; e < 2; ++e) { const int t = t0 + e * (NGW >> 1); if (t >= TCH) continue;
                float of[8], ob[8], vv[8], gr[8], o[8];
                unpack8(r_of[e], of); unpack8(r_ob[e], ob); unpack8(r_v[e], vv); unpack8(r_g[e], gr);
                float sm = 0.f;
#pragma unroll
                for (int i = 0; i < 8; ++i) { o[i] = of[i] + ob[i]; sm += o[i]; }
                sm += dpp_mov<0xB1>(sm); sm += dpp_mov<0x4E>(sm); sm += dpp_mov<0x141>(sm);
                const float mu = sm * (1.0f / 64.0f); float vs = 0.f;
#pragma unroll
                for (int i = 0; i < 8; ++i) { o[i] -= mu; vs = fmaf(o[i], o[i], vs); }
                vs += dpp_mov<0xB1>(vs); vs += dpp_mov<0x4E>(vs); vs += dpp_mov<0x141>(vs);
                const float rs = 1.0f / sqrtf(vs * (1.0f / 64.0f) + 64e-5f), bn = r_bn[e];
                float y[8];
#pragma unroll
                for (int i = 0; i < 8; ++i) { const float lg = i < 4 ? lg0[i] : lg1[i - 4], lb = i < 4 ? lb0[i] : lb1[i - 4];
                    y[i] = (o[i] * rs * lg + lb + bn * vv[i]) * gr[i] * fsigmoid(gr[i]); }
                *(u32x4*)(OA + (size_t)t * 2048 + 1024 + hc) = pack8((f32x4){y[0], y[1], y[2], y[3]}, (f32x4){y[4], y[5], y[6], y[7]}); }
        }
    }
}

#define XB_TMO      128
#define XB_XCNT(j)  (256  + 64 * (j))
#define XB_XSUB(j)  (1280 + 64 * (j))
#define XB_XGEN(j)  (2304 + 64 * (j))
#define XB_TOP      3328
#define XB_TOPGEN   3392
#define XCD_BAR_WORDS 3456
#define XB_SPIN_CAP (1u << 20)
__device__ __forceinline__ unsigned xb_ld(unsigned* p)              { return __hip_atomic_load(p, __ATOMIC_RELAXED, __HIP_MEMORY_SCOPE_AGENT); }
__device__ __forceinline__ unsigned xb_add(unsigned* p, unsigned v) { return __hip_atomic_fetch_add(p, v, __ATOMIC_RELAXED, __HIP_MEMORY_SCOPE_AGENT); }
__device__ __forceinline__ unsigned xb_xcc_id() { return (unsigned)__builtin_amdgcn_s_getreg((3 << 11) | 20) & 0xFu; }
#define XB_SPIN(cond, bar) do { unsigned _sp = 0; while (cond) { __builtin_amdgcn_s_sleep(0); \
    if ((++_sp & 255u) == 0u) { if (xb_ld(&(bar)[XB_TMO])) break; if (_sp > XB_SPIN_CAP) { atomicAdd(&(bar)[XB_TMO], 1u); break; } } } } while (0)
__device__ __forceinline__ void xcd_barrier_complete(unsigned* bar, unsigned x, unsigned G, unsigned& nloc, unsigned& nx) {
    unsigned sum, cnt, mine, sp = 0u;
    for (;;) {
        sum = 0u; cnt = 0u; mine = 0u;
#pragma unroll
        for (unsigned j = 0; j < 16; ++j) { const unsigned c = xb_ld(&bar[XB_XCNT(j)]); sum += c; cnt += (c > 0u) ? 1u : 0u; mine = (j == x) ? c : mine; }
        if (sum == G) break;
        __builtin_amdgcn_s_sleep(1);
        if ((++sp & 255u) == 0u) { if (xb_ld(&bar[XB_TMO])) break; if (sp > XB_SPIN_CAP) { atomicAdd(&bar[XB_TMO], 1u); break; } }
    }
    nloc = mine > 0u ? mine : 1u; nx = cnt > 0u ? cnt : 1u;
}
__device__ __forceinline__ void xcd_barrier(unsigned* bar, volatile LAS unsigned* st, const bool t0, const unsigned G) {
    asm volatile("s_waitcnt vmcnt(0)" ::: "memory");
    __syncthreads();
    if (t0) {
        __builtin_amdgcn_s_waitcnt(0);
        const unsigned x = xb_xcc_id();
        unsigned nloc = st[0], nx = st[1];
        if (nloc == 0u) { xcd_barrier_complete(bar, x, G, nloc, nx); st[0] = nloc; st[1] = nx; }
        const unsigned old = xb_add(&bar[XB_XSUB(x)], 1u);
        const unsigned gen = old / nloc;
        if (old + 1u == (gen + 1u) * nloc) {
            __builtin_amdgcn_fence(__ATOMIC_RELEASE, "agent");
            asm volatile("s_waitcnt vmcnt(0)" ::: "memory");
            const unsigned og = xb_add(&bar[XB_TOP], 1u);
            const unsigned tg = og / nx;
            if (og + 1u == (tg + 1u) * nx) xb_add(&bar[XB_TOPGEN], 1u);
            else XB_SPIN(xb_ld(&bar[XB_TOPGEN]) == tg, bar);
            __builtin_amdgcn_fence(__ATOMIC_ACQUIRE, "agent");
            xb_add(&bar[XB_XGEN(x)], 1u);
            asm volatile("s_waitcnt vmcnt(0)" ::: "memory");
        } else {
            XB_SPIN(xb_ld(&bar[XB_XGEN(x)]) == gen, bar);
            __builtin_amdgcn_fence(__ATOMIC_ACQUIRE, "agent");
            asm volatile("s_waitcnt vmcnt(0)" ::: "memory");
        }
    }
    __syncthreads();
}

constexpr int N_PHASES = 1 + 6 * NCHUNK + 1;
#define GET_TID() int wave = wave0; asm volatile("" : "+s"(wave)); \
        unsigned zz = 0u; asm volatile("" : "+v"(zz)); \
        int tid = wave * 64 + (int)__builtin_amdgcn_mbcnt_hi(~0u, __builtin_amdgcn_mbcnt_lo(~0u, zz)); asm volatile("" : "+v"(tid)); \
        int bid = blockIdx.x; asm volatile("" : "+s"(bid)); int G = G0; asm volatile("" : "+s"(G)); \
        const int lane = tid & 63; const int gw = bid * NWAVES + wave, NGW = G * NWAVES; (void)lane; (void)gw; (void)NGW;
#if defined(__HIP_DEVICE_COMPILE__)
#define LOAD_ARGS() typedef const __attribute__((address_space(4))) Args* CArgsP; \
        CArgsP ap = (CArgsP)__builtin_amdgcn_kernarg_segment_ptr(); \
        asm volatile("" : "+s"(ap)); \
        Args a; \
        a.x_p = ap->x_p; a.x_s = ap->x_s; a.norm_g = ap->norm_g; a.w_in = ap->w_in; a.conv = ap->conv; a.lq1 = ap->lq1; a.lk1 = ap->lk1; a.lq2 = ap->lq2; a.lk2 = ap->lk2; \
        a.subln_g = ap->subln_g; a.wlu = ap->wlu; a.w0 = ap->w0; a.alu = ap->alu; a.a0 = ap->a0; a.k_k = ap->k_k; a.k_a = ap->k_a; a.r_k = ap->r_k; a.lnx_g = ap->lnx_g; a.lnx_b = ap->lnx_b; \
        a.w_oa = ap->w_oa; a.w_or = ap->w_or; a.w_out = ap->w_out; a.final_g = ap->final_g; a.out = ap->out; a.ws = ap->ws; a.ph_lo = 0; a.ph_hi = 0; \
        unsigned char* ws = a.ws; unsigned* ctl = (unsigned*)(ws + WS_CTL); bf16_t* XN = (bf16_t*)(ws + WS_XN); bf16_t* H = (bf16_t*)(ws + WS_H); (void)ctl; (void)XN; (void)H;
#else
#define LOAD_ARGS() Args a = a_in; unsigned char* ws = a.ws; unsigned* ctl = (unsigned*)(ws + WS_CTL); bf16_t* XN = (bf16_t*)(ws + WS_XN); bf16_t* H = (bf16_t*)(ws + WS_H); (void)ctl; (void)XN; (void)H;
#endif
__global__ void __launch_bounds__(NTHR, 2) mega_fwd(Args a_in) {
    extern __shared__ __attribute__((aligned(16))) unsigned char lds_raw[];
    LAS unsigned char* lds = (LAS unsigned char*)lds_raw;
    cg::grid_group grid = cg::this_grid();
    const int G0 = gridDim.x;
    volatile LAS unsigned* misc = (volatile LAS unsigned*)(lds + LDS_BYTES - 64);
#ifndef PH_MASK
#define PH_MASK 0xff
#endif
#define PROBE_DUP 0
    const int ph_lo = a_in.ph_lo, ph_hi = a_in.ph_hi;
    const int wave0 = __builtin_amdgcn_readfirstlane(threadIdx.x >> 6);
    if (threadIdx.x < 8) misc[threadIdx.x + 8] = 0u;
    __syncthreads();
    if (threadIdx.x == 0) (void)xb_add((unsigned*)(a_in.ws + WS_CTL) + 4096 + XB_XCNT(xb_xcc_id()), 1u);
    for (int p = ph_lo; p < ph_hi; ++p) {
        if (p == 0) { if (!(PH_MASK & 1)) continue; LOAD_ARGS(); GET_TID();
            for (int rep = 0; rep < ((PROBE_DUP & 64) ? 3 : 1); ++rep) {
            phase_weights(a, lds, gw, NGW, lane, wave);
            phase_xn(a.x_p, a.norm_g, XN, TCH, gw, NGW, lane); }
        } else if (p == N_PHASES - 1) { if (!(PH_MASK & 128)) continue; LOAD_ARGS(); GET_TID();
            phase_final(a.out + (size_t)(NCHUNK - 1) * TCH * DM, a.final_g, TCH, gw, NGW, lane);
        } else {
            const int ch = (p - 1) / 6, sub = (p - 1) % 6;
            const int S = ch < 4 ? 2048 : 4096, nb = TCH / S;
            const size_t grow = (size_t)ch * TCH;
            if (sub == 0) { if (!(PH_MASK & 2) || ch >= 1) continue; LOAD_ARGS(); GET_TID();
                {
                pg8::Gemm g{XN, (const bf16_t*)(ws + WS_WIN), TCH, PIN, DM, DM, DM}; pg8::StaticOrder So; So.init(TCH, PIN, G, bid, (PROBE_DUP & 1) ? 2 : 1);
                EpiIn E{H, (bf16_t*)(ws + WS_LW), (const f32x4*)(ws + WS_ROPE), S - 1}; pg8::gemm_phase<DM, DM>(lds, g, So, E, tid); }
            } else if (sub == 1) { if (!(PH_MASK & 4)) continue; LOAD_ARGS(); GET_TID();
#ifndef NO_PREP
                phase_prep(a, S, gw, NGW, lane, false);
#endif
                { if (PROBE_DUP & 2) phase_prep(a, S, gw, NGW, lane, false);
                pg8::Gemm g{(const bf16_t*)(ws + WS_LW), (const bf16_t*)(ws + WS_WLORA), TCH, 4096, 256, 256, 256}; pg8::StaticOrder So; So.init(TCH, 4096, G, bid, (PROBE_DUP & 4) ? 2 : 1);
                EpiLora E{(bf16_t*)(ws + WS_LORA), a.w0, a.a0}; pg8::gemm_phase<256, 256>(lds, g, So, E, tid); }
            } else if (sub == 2) { if (!(PH_MASK & 8)) continue; LOAD_ARGS(); GET_TID();
                const int nscan = nb * 32, nqb = S / 256, natt = nb * 16 * nqb;
                const size_t gnx = grow + TCH;
                const float* xnext = (ch + 1 < NCHUNK) ? (ch + 1 < 4 ? a.x_p + gnx * DM : a.x_s + (gnx - NTOK_P) * DM) : (const float*)nullptr;
                float* oprev = (ch >= 1) ? a.out + (grow - TCH) * DM : (float*)nullptr;
#ifndef PROBE_MIX
#define PROBE_MIX 0
#endif
                for (int rep = 0; rep < (PROBE_MIX ? 2 : 1); ++rep)
                for (;;) {
                    if (tid == 0) misc[0] = atomicAdd(ctl + ch + 8 * rep, 1u);
                    __syncthreads(); unsigned u = misc[0]; __syncthreads();
                    if (rep == 1 && PROBE_MIX == 2) u += nscan;
                    if (rep == 1 && PROBE_MIX == 1 && u >= (unsigned)nscan) break;
                    if (u >= (unsigned)(nscan + natt)) break;
                    int tid_u = tid; asm volatile("" : "+v"(tid_u));
                    if (u < (unsigned)nscan) { const int ar = TCH / nscan;
                        cs::scan_unit(a, u >> 5, (u >> 1) & 15, u & 1, S, lds, tid_u, xnext, (bf16_t*)(ws + (((ch + 1) & 1) ? WS_XN1 : WS_XN)), oprev, (int)u * ar, ar); }
                    else { const int v = u - nscan, qb = v % nqb, hm = (v / nqb) & 15, b = v / (nqb * 16);
                        const size_t r0 = (size_t)b * S;
                        att::attn_body(H + (r0 + qb * 256) * PIN + C_Q + hm * 64, H + r0 * PIN + C_K + hm * 64, H + r0 * PIN + C_V + (hm >> 1) * 128,
                                       (bf16_t*)(ws + WS_ATT) + (r0 + qb * 256) * 2048 + hm * 128, S, (char*)lds_raw, tid_u); }
                }
            } else if (sub == 3) { if (!(PH_MASK & 16)) continue; LOAD_ARGS(); GET_TID();
                for (int rep = 0; rep < ((PROBE_DUP & 8) ? 2 : 1); ++rep) phase_post(a, gw, NGW, lane);
            } else if (sub == 4) { if (!(PH_MASK & 32)) continue; LOAD_ARGS(); GET_TID();
                {
                { pg8::Gemm g{(const bf16_t*)(ws + WS_OA), (const bf16_t*)(ws + WS_WOA), TCH, DM, 2048, 2048, 2048}; pg8::StaticOrder So; So.init(TCH, DM, G, bid, (PROBE_DUP & 16) ? 2 : 1);
                  EpiMix E{(bf16_t*)(ws + WS_M), H}; pg8::gemm_phase<2048, 2048>(lds, g, So, E, tid); } }
            } else { if (!(PH_MASK & 64)) continue; LOAD_ARGS(); GET_TID();
                { pg8::Gemm g{(const bf16_t*)(ws + WS_M), (const bf16_t*)(ws + WS_WOUT), TCH, DM, DM, DM, DM}; pg8::StaticOrder So; So.init(TCH, DM, G, bid, (PROBE_DUP & 32) ? 2 : 1);
                  const float* xc = ch < 4 ? a.x_p + grow * DM : a.x_s + (grow - NTOK_P) * DM; EpiOut E{a.out + grow * DM, xc}; pg8::gemm_phase<DM, DM>(lds, g, So, E, tid); }
                if (ch + 1 < NCHUNK) {
                    int tid2 = tid; asm volatile("" : "+v"(tid2));
                    pg8::Gemm g{(const bf16_t*)(ws + (((ch + 1) & 1) ? WS_XN1 : WS_XN)), (const bf16_t*)(ws + WS_WIN), TCH, PIN, DM, DM, DM}; pg8::StaticOrder So; So.init(TCH, PIN, G, bid);
                    EpiIn E{H, (bf16_t*)(ws + WS_LW), (const f32x4*)(ws + WS_ROPE), (ch + 1 < 4 ? 2048 : 4096) - 1}; pg8::gemm_phase<DM, DM>(lds, g, So, E, tid2); }
            }
        }
        if (p + 1 < ph_hi) {
            if (p == 0) grid.sync();
            else { int wv = wave0; asm volatile("" : "+s"(wv)); unsigned z3 = 0u; asm volatile("" : "+v"(z3));
                   const bool t0 = (wv == 0) && (__builtin_amdgcn_mbcnt_hi(~0u, __builtin_amdgcn_mbcnt_lo(~0u, z3)) == 0u);
                   xcd_barrier((unsigned*)(a_in.ws + WS_CTL) + 4096, misc + 8, t0, (unsigned)G0); }
        }
    }
}

extern "C" void kernel_launch(void* const* d_in, const int* in_sizes, int n_in, void* d_out, int out_size, void* d_ws, size_t ws_size, hipStream_t stream) {
    static int grid = 0;
    if (grid == 0) {
        if (n_in != 23 || ws_size < WS_END) { fprintf(stderr, "kernel_launch: unexpected n_in %d / ws %zu\n", n_in, ws_size); grid = -1; return; }
        int dev = 0, cus = 0, per_cu = 0;
        hipGetDevice(&dev); hipDeviceGetAttribute(&cus, hipDeviceAttributeMultiprocessorCount, dev);
        hipFuncSetAttribute((const void*)mega_fwd, hipFuncAttributeMaxDynamicSharedMemorySize, LDS_BYTES);
        hipOccupancyMaxActiveBlocksPerMultiprocessor(&per_cu, (const void*)mega_fwd, NTHR, LDS_BYTES);
        if (per_cu < 1) { fprintf(stderr, "kernel_launch: occupancy query says %d\n", per_cu); per_cu = 1; }
        grid = cus * 1;
    }
    if (grid < 0) return;
    if (hipMemsetAsync((char*)d_ws + WS_CTL, 0, 65536, stream) != hipSuccess) { fprintf(stderr, "kernel_launch: memset failed\n"); return; }
    Args a{};
    const float** f = (const float**)&a;
    for (int i = 0; i < 23; ++i) f[i] = (const float*)d_in[i];
    a.out = (float*)d_out; a.ws = (unsigned char*)d_ws; a.ph_lo = 0; a.ph_hi = N_PHASES;
    void* args[] = {&a};
    hipError_t e = hipLaunchCooperativeKernel((const void*)mega_fwd, dim3(grid), dim3(NTHR), args, LDS_BYTES, stream);
    if (e != hipSuccess) fprintf(stderr, "cooperative launch failed: %s (grid %d)\n", hipGetErrorString(e), grid);
}
```
